# Optimizing an MI355X kernel written in HIP

```python
import math
import jax
import jax.numpy as jnp
from jax import lax
import numpy as np

D_MODEL = 2048
BATCH = 4
SEQ = 4096
DEPTH = 1
DEC_BATCH = 4
DEC_SEQ = 8192
PAST_LEN = 128

ATTN_HEADS = 8
ATTN_QK_DIM = 64
ATTN_V_DIM = 2 * ATTN_QK_DIM
ATTN_QK_WIDTH = ATTN_HEADS * 2 * ATTN_QK_DIM
ATTN_WIDTH = ATTN_HEADS * ATTN_V_DIM
HYENA_WIDTH = D_MODEL // 2
HYENA_PROJ = 3
HYENA_EMB_DIM = 33
HYENA_BANDS = (HYENA_EMB_DIM - 1) // 2
FILTER_WIDTH = 64
DECAY_TARGET = 1e-2
FAST_DECAY_PCT = 0.3
SLOW_DECAY_PCT = 1.5
SHORT_CONV = 3
N_BRANCH = 2
D_FF = 5632
ROPE_THETA = 10000.0
NORM_EPS = 1e-6
Q_BLOCK = 128
IN_WIDTH = 2 * ATTN_QK_WIDTH + ATTN_WIDTH + HYENA_PROJ * HYENA_WIDTH + N_BRANCH * D_MODEL

kernel_name = "hybrid_diffattn_hyena_encoder"


def rmsnorm(x, g):
    xf = x.astype(jnp.float32)
    xf = xf * lax.rsqrt(jnp.mean(xf * xf, axis=-1, keepdims=True) + NORM_EPS)
    return (xf * g.astype(jnp.float32)).astype(x.dtype)


def dwconv3(x, w, b):
    L = x.shape[1]
    xp = jnp.pad(x, ((0, 0), (1, 1), (0, 0)))
    return xp[:, 0:L] * w[0] + xp[:, 1:L + 1] * w[1] + xp[:, 2:L + 2] * w[2] + b


def rope(x):
    L, d = x.shape[1], x.shape[-1]
    inv = ROPE_THETA ** (-jnp.arange(0, d, 2, dtype=jnp.float32) / d)
    ang = jnp.arange(L, dtype=jnp.float32)[:, None] * inv[None]
    ang = jnp.concatenate([ang, ang], -1)[:, None, None, :]
    xf = x.astype(jnp.float32)
    rot = jnp.concatenate([-xf[..., d // 2:], xf[..., :d // 2]], -1)
    return (xf * jnp.cos(ang) + rot * jnp.sin(ang)).astype(x.dtype)


def diff_attention(q, k, v, lam):
    B, L, H = q.shape[:3]
    nb = L // Q_BLOCK
    scale = ATTN_QK_DIM ** -0.5
    qb = jnp.moveaxis(q.reshape(B, nb, Q_BLOCK, H, 2, ATTN_QK_DIM), 1, 0)
    vf = v.astype(jnp.float32)

    def block(qi):
        s = jnp.einsum("bqhmd,bkhmd->bhmqk", qi, k, preferred_element_type=jnp.float32) * scale
        p = jax.nn.softmax(s, axis=-1)
        a = p[:, :, 0] - lam * p[:, :, 1]
        return jnp.einsum("bhqk,bkhd->bqhd", a, vf).astype(v.dtype)

    o = lax.map(block, qb)
    return jnp.moveaxis(o, 0, 1).reshape(B, L, H, ATTN_V_DIM)


def hyena_filters(L, w1, b1, w2, b2, w3, b3, w4, freq):
    t = jnp.linspace(0.0, 1.0, L, dtype=jnp.float32)[:, None]
    w = 2.0 * math.pi * jnp.arange(L, dtype=jnp.float32)[:, None] / L
    f = jnp.linspace(1e-4, HYENA_BANDS - 1, HYENA_BANDS, dtype=jnp.float32)[None]
    z = jnp.concatenate([t, jnp.cos(f * w), -jnp.sin(f * w)], -1)
    h = jnp.sin(freq * (z @ w1 + b1))
    h = jnp.sin(freq * (h @ w2 + b2))
    h = jnp.sin(freq * (h @ w3 + b3))
    h = (h @ w4).astype(jnp.float32).reshape(L, 2, HYENA_WIDTH)
    max_decay = math.log(DECAY_TARGET) / FAST_DECAY_PCT
    min_decay = math.log(DECAY_TARGET) / SLOW_DECAY_PCT
    deltas = jnp.abs(jnp.linspace(min_decay, max_decay, HYENA_WIDTH, dtype=jnp.float32))
    h = h * jnp.exp(-t * deltas[None])[:, None, :]
    return h[:, 0], h[:, 1]


def fftconv_bidir(u, h_fwd, h_bwd, bias):
    L, C = h_fwd.shape
    n = 2 * L
    filt = jnp.concatenate([h_fwd, jnp.zeros((1, C), jnp.float32), h_bwd[1:][::-1]], 0)
    Hf = jnp.fft.rfft(filt, n=n, axis=0)
    U = jnp.fft.rfft(u.astype(jnp.float32), n=n, axis=1)
    y = jnp.fft.irfft(U * Hf[None], n=n, axis=1)[:, :L]
    return (y + u.astype(jnp.float32) * bias.astype(jnp.float32)).astype(u.dtype)


def encoder_layer(x, lambda_init, norm1, w_in, in_conv_w, in_conv_b, gate_b,
                  lambda_q1, lambda_k1, lambda_q2, lambda_k2, subln_g,
                  filt_w1, filt_b1, filt_w2, filt_b2, filt_w3, filt_b3, filt_w4, filt_freq,
                  hyena_bias, w_attn_out, w_hyena_out, w_out,
                  norm2, w_up, ffn_conv_w, ffn_conv_b, w_down):
    B, L, _ = x.shape
    hn = rmsnorm(x, norm1)
    proj = hn @ w_in
    o1 = ATTN_QK_WIDTH
    o2 = o1 + ATTN_QK_WIDTH
    o3 = o2 + ATTN_WIDTH
    o4 = o3 + HYENA_PROJ * HYENA_WIDTH
    q, k, v, hy, gl = jnp.split(proj, [o1, o2, o3, o4], axis=-1)

    q = rope(q.reshape(B, L, ATTN_HEADS, 2, ATTN_QK_DIM))
    k = rope(k.reshape(B, L, ATTN_HEADS, 2, ATTN_QK_DIM))
    v = v.reshape(B, L, ATTN_HEADS, ATTN_V_DIM)
    lam = (jnp.exp(jnp.sum(lambda_q1.astype(jnp.float32) * lambda_k1.astype(jnp.float32)))
           - jnp.exp(jnp.sum(lambda_q2.astype(jnp.float32) * lambda_k2.astype(jnp.float32)))
           + lambda_init)
    attn = diff_attention(q, k, v, lam)
    attn = (rmsnorm(attn, subln_g) * (1.0 - lambda_init)).reshape(B, L, ATTN_WIDTH)

    hy = dwconv3(hy, in_conv_w, in_conv_b)
    x0, x1, hv = jnp.split(hy, HYENA_PROJ, axis=-1)
    h_fwd, h_bwd = hyena_filters(L, filt_w1, filt_b1, filt_w2, filt_b2, filt_w3, filt_b3,
                                 filt_w4, filt_freq)
    hyena = fftconv_bidir(hv * x1, h_fwd, h_bwd, hyena_bias) * x0

    gates = jax.nn.sigmoid(gl.reshape(B, L, N_BRANCH, D_MODEL) + gate_b.reshape(N_BRANCH, D_MODEL))
    merged = gates[:, :, 0] * (attn @ w_attn_out) + gates[:, :, 1] * (hyena @ w_hyena_out)
    x = x + merged @ w_out

    hn = rmsnorm(x, norm2)
    u = dwconv3(hn @ w_up, ffn_conv_w, ffn_conv_b)
    ug, uv = jnp.split(u, 2, axis=-1)
    return x + (jax.nn.silu(ug) * uv) @ w_down


def setup_inputs(seed: int = 0) -> dict:
    key = jax.random.key(seed)
    ks = jax.random.split(key, 40)
    counter = [0]

    def nrm(shape, scale):
        k = ks[counter[0]]
        counter[0] += 1
        return jax.random.normal(k, shape, jnp.float32) * scale

    def gain(shape):
        return 1.0 + nrm(shape, 0.02)

    C = HYENA_WIDTH
    inputs = {}
    inputs["x_prompt"] = nrm((BATCH, SEQ, D_MODEL), 1.0)
    inputs["x_sample"] = nrm((DEC_BATCH, DEC_SEQ, D_MODEL), 1.0)
    inputs["norm1"] = gain((DEPTH, D_MODEL))
    inputs["w_in"] = nrm((DEPTH, D_MODEL, IN_WIDTH), D_MODEL ** -0.5)
    inputs["in_conv_w"] = nrm((DEPTH, SHORT_CONV, HYENA_PROJ * C), 0.5)
    inputs["in_conv_b"] = nrm((DEPTH, HYENA_PROJ * C), 0.02)
    inputs["gate_b"] = nrm((DEPTH, N_BRANCH * D_MODEL), 0.1)
    inputs["lambda_q1"] = nrm((DEPTH, ATTN_QK_DIM), 0.1)
    inputs["lambda_k1"] = nrm((DEPTH, ATTN_QK_DIM), 0.1)
    inputs["lambda_q2"] = nrm((DEPTH, ATTN_QK_DIM), 0.1)
    inputs["lambda_k2"] = nrm((DEPTH, ATTN_QK_DIM), 0.1)
    inputs["subln_g"] = gain((DEPTH, ATTN_V_DIM))
    inputs["filt_w1"] = nrm((DEPTH, HYENA_EMB_DIM, FILTER_WIDTH), HYENA_EMB_DIM ** -0.5)
    inputs["filt_b1"] = nrm((DEPTH, FILTER_WIDTH), 0.1)
    inputs["filt_w2"] = nrm((DEPTH, FILTER_WIDTH, FILTER_WIDTH), FILTER_WIDTH ** -0.5)
    inputs["filt_b2"] = nrm((DEPTH, FILTER_WIDTH), 0.1)
    inputs["filt_w3"] = nrm((DEPTH, FILTER_WIDTH, FILTER_WIDTH), FILTER_WIDTH ** -0.5)
    inputs["filt_b3"] = nrm((DEPTH, FILTER_WIDTH), 0.1)
    inputs["filt_w4"] = nrm((DEPTH, FILTER_WIDTH, 2 * C), 0.1 * FILTER_WIDTH ** -0.5)
    inputs["filt_freq"] = 1.0 + nrm((DEPTH, FILTER_WIDTH), 0.1)
    inputs["hyena_bias"] = nrm((DEPTH, C), 0.1)
    inputs["w_attn_out"] = nrm((DEPTH, ATTN_WIDTH, D_MODEL), ATTN_WIDTH ** -0.5)
    inputs["w_hyena_out"] = nrm((DEPTH, C, D_MODEL), C ** -0.5)
    inputs["w_out"] = nrm((DEPTH, D_MODEL, D_MODEL), D_MODEL ** -0.5)
    inputs["norm2"] = gain((DEPTH, D_MODEL))
    inputs["w_up"] = nrm((DEPTH, D_MODEL, 2 * D_FF), D_MODEL ** -0.5)
    inputs["ffn_conv_w"] = nrm((DEPTH, SHORT_CONV, 2 * D_FF), 0.5)
    inputs["ffn_conv_b"] = nrm((DEPTH, 2 * D_FF), 0.02)
    inputs["w_down"] = nrm((DEPTH, D_FF, D_MODEL), D_FF ** -0.5)
    inputs["norm_f"] = gain((D_MODEL,))
    return inputs


def reference(x_prompt, x_sample, norm1, w_in, in_conv_w, in_conv_b, gate_b,
              lambda_q1, lambda_k1, lambda_q2, lambda_k2, subln_g,
              filt_w1, filt_b1, filt_w2, filt_b2, filt_w3, filt_b3, filt_w4, filt_freq,
              hyena_bias, w_attn_out, w_hyena_out, w_out,
              norm2, w_up, ffn_conv_w, ffn_conv_b, w_down, norm_f):
    params = (norm1, w_in, in_conv_w, in_conv_b, gate_b,
              lambda_q1, lambda_k1, lambda_q2, lambda_k2, subln_g,
              filt_w1, filt_b1, filt_w2, filt_b2, filt_w3, filt_b3, filt_w4, filt_freq,
              hyena_bias, w_attn_out, w_hyena_out, w_out,
              norm2, w_up, ffn_conv_w, ffn_conv_b, w_down)

    def trunk(x):
        for i in range(DEPTH):
            lambda_init = 0.8 - 0.6 * math.exp(-0.3 * i)
            x = encoder_layer(x, lambda_init, *[p[i] for p in params])
        return rmsnorm(x, norm_f)

    y_prompt = trunk(x_prompt)
    y_sample = trunk(x_sample)
    return (y_prompt, y_sample)
```

```cpp
#include <hip/hip_runtime.h>
#include <hip/hip_cooperative_groups.h>
#include <cstdio>
#include <cstdint>
namespace cg = cooperative_groups;

#define LAS __attribute__((address_space(3)))
typedef unsigned short bf16_t;
typedef short bf16x8 __attribute__((ext_vector_type(8)));
typedef short s16x4 __attribute__((ext_vector_type(4)));
typedef float f32x2 __attribute__((ext_vector_type(2)));
typedef float f32x4 __attribute__((ext_vector_type(4)));
typedef float f32x16 __attribute__((ext_vector_type(16)));
typedef unsigned u32x2 __attribute__((ext_vector_type(2)));
typedef unsigned u32x4 __attribute__((ext_vector_type(4)));

constexpr int DM = 2048, CH = 16384, NCHUNK = 3;
constexpr int INW = 10240, DFF = 5632, UPW = 11264;
constexpr float EPS = 1e-6f;
constexpr float QSCALE = 0.125f * 1.4426950408889634f;
constexpr float LAMBDA_INIT = 0.2f;

constexpr size_t MiB = 1u << 20;
constexpr size_t WS_PART1 = 0, WS_PART2 = 2 * MiB, WS_RSTD1 = 4 * MiB, WS_ROPE = 5 * MiB, WS_H3 = 7 * MiB;
constexpr size_t WS_WIN = 10 * MiB, WS_WUP = 50 * MiB, WS_WDN = 94 * MiB, WS_WOUT = 116 * MiB, WS_WA = 124 * MiB, WS_WH = 128 * MiB;
constexpr size_t WS_F4 = 132 * MiB, WS_F8 = 164 * MiB;
constexpr size_t WS_R23 = 228 * MiB;
constexpr size_t WS_R1 = 404 * MiB;
constexpr size_t WS_XB = 916 * MiB;
constexpr size_t WS_CTL = 980 * MiB, CTL_BYTES = 16384;
constexpr size_t WS_END = 981 * MiB;
constexpr size_t R1_QB = 0, R1_KB = 32 * MiB, R1_VB = 64 * MiB, R1_HY = 96 * MiB, R1_GT = 192 * MiB, R1_AT = 320 * MiB, R1_HN = 352 * MiB, R1_UT = 384 * MiB, R1_YT = 416 * MiB, R1_XT = 448 * MiB;

struct Params { const float* in[30]; float* out; unsigned char* ws; };

__device__ __forceinline__ float bflo(unsigned w) { return __uint_as_float(w << 16); }
__device__ __forceinline__ float bfhi(unsigned w) { return __uint_as_float(w & 0xffff0000u); }
__device__ __forceinline__ float bf2f(unsigned short h) { return __uint_as_float((unsigned)h << 16); }
__device__ __forceinline__ unsigned f2bf(float f) { unsigned u = __float_as_uint(f); return (u + 0x7fffu + ((u >> 16) & 1u)) >> 16; }
__device__ __forceinline__ unsigned pk2(float lo, float hi) { return f2bf(lo) | (f2bf(hi) << 16); }
typedef __bf16 bf16x2_t __attribute__((ext_vector_type(2)));
__device__ __forceinline__ unsigned cvt_pk_bf16(float lo, float hi) { f32x2 v = {lo, hi}; bf16x2_t b = __builtin_convertvector(v, bf16x2_t); return __builtin_bit_cast(unsigned, b); }
__device__ __forceinline__ float lane_xor_get(float v, int lane, int o) { return __int_as_float(__builtin_amdgcn_ds_bpermute((lane ^ o) << 2, __float_as_int(v))); }
__device__ __forceinline__ float wave_sum(float v, int lane) {
#pragma unroll
    for (int o = 1; o < 64; o <<= 1) v += lane_xor_get(v, lane, o);
    return v;
}
__device__ __forceinline__ float swap_add(float v) { auto rr = __builtin_amdgcn_permlane32_swap(__float_as_uint(v), __float_as_uint(v), false, false); return __uint_as_float(rr[0]) + __uint_as_float(rr[1]); }
__device__ __forceinline__ float swap_max(float v) { auto rr = __builtin_amdgcn_permlane32_swap(__float_as_uint(v), __float_as_uint(v), false, false); return fmaxf(__uint_as_float(rr[0]), __uint_as_float(rr[1])); }
__device__ __forceinline__ u32x4 zero4() { unsigned z = 0u; asm volatile("" : "+v"(z)); return (u32x4){z, z, z, z}; }
__device__ __forceinline__ void sincos_d(double x, double& s, double& c) {
    const double k = rint(x * 0.63661977236758134308);
    double r = fma(-k, 1.57079632679489655800e+00, x);
    r = fma(-k, 6.12323399573676603587e-17, r);
    const double r2 = r * r;
    const double sp = r * (1.0 + r2 * (-1.0 / 6.0 + r2 * (1.0 / 120.0 + r2 * (-1.0 / 5040.0 + r2 * (1.0 / 362880.0 + r2 * (-1.0 / 39916800.0 + r2 * (1.0 / 6227020800.0)))))));
    const double cp = 1.0 + r2 * (-0.5 + r2 * (1.0 / 24.0 + r2 * (-1.0 / 720.0 + r2 * (1.0 / 40320.0 + r2 * (-1.0 / 3628800.0 + r2 * (1.0 / 479001600.0 + r2 * (-1.0 / 87178291200.0)))))));
    const int q = ((int)k) & 3;
    const double ss = (q & 1) ? cp : sp, cc = (q & 1) ? sp : cp;
    s = (q & 2) ? -ss : ss;
    c = ((q + 1) & 2) ? -cc : cc;
}
__device__ __forceinline__ float sin_f(float x) { double s, c; sincos_d((double)x, s, c); return (float)s; }

namespace pg8 {
constexpr int BM = 256, BK = 64, HALF = 128, HTB = HALF * BK * 2, STAGE_BYTES = 8 * HTB, NXCD = 8, WGM = 8;
__host__ __device__ __forceinline__ int lds_byte(int r, int c) { const int st = (r >> 4) * 2 + (c >> 5), rr = r & 15, cc = c & 31, ob = rr * 64 + cc * 2; return st * 1024 + (ob ^ (((ob >> 9) & 1) << 5)); }
__host__ __device__ __forceinline__ void stage_rc(int b, int& R, int& C) { const int st = b / 1024, sb = b % 1024, swz = sb ^ (((sb >> 9) & 1) << 5); R = (st >> 1) * 16 + swz / 64; C = (st & 1) * 32 + (swz % 64) / 2; }
__host__ __device__ __forceinline__ int perm32(int rho) { const int n = rho >> 4, i = rho & 15; return 8 * (i >> 2) + 4 * n + (i & 3); }
struct Unit { int pm, pn; };
struct Gemm { const bf16_t* A; const bf16_t* Bt; int M, N, K; };
struct StaticOrder {
    int nM, nN, nwg, G, c;
    __device__ void init(int M, int N, int G_, int c_) { nM = M / BM; nN = N / BM; nwg = nM * nN; G = G_; c = c_; }
    __device__ bool next(int i, Unit& u) const {
        const long L = (long)i * G + c; if (L >= nwg) return false;
        int wgid = (int)L; { const int q = nwg / NXCD, r = nwg % NXCD, xcd = wgid % NXCD, off = wgid / NXCD; wgid = (xcd < r ? xcd * (q + 1) : r * (q + 1) + (xcd - r) * q) + off; }
        const int nig = WGM * nN, gid = wgid / nig, fm = gid * WGM, gsz = (nM - fm) < WGM ? (nM - fm) : WGM;
        u.pm = fm + ((wgid % nig) % gsz); u.pn = (wgid % nig) / gsz; return true;
    }
};
template <class Epi, bool ALIGN_EPI>
__device__ __forceinline__ void gemm_phase(LAS unsigned char* lds, const Gemm g, const StaticOrder& S, const Epi& E) {
    int tid = threadIdx.x; asm volatile("" : "+v"(tid));
    const int wid = __builtin_amdgcn_readfirstlane(tid >> 6), lane = tid & 63, wr = wid >> 2, wc = wid & 3, fr = lane & 15, fq = lane >> 4;
    const int K = g.K, nt = K / BK;
    unsigned voffA[2], voffB[2];
#pragma unroll
    for (int i = 0; i < 2; ++i) { int R, C; stage_rc(tid * 16 + i * 8192, R, C); const int Rb = Epi::PERM ? ((R & ~31) + perm32(R & 31)) : R;
        voffA[i] = (unsigned)(R * K + C) * 2u; voffB[i] = (unsigned)(Rb * K + C) * 2u; }
    const size_t kstep = (size_t)(BK * 2);
    const size_t hstep = (size_t)HALF * K * 2;
    const size_t tstep = 2 * hstep;
    const unsigned ldsw = (unsigned)wid * 1024u;
    const int aoff = lds_byte(wr * 64 + fr, fq * 8), boff = lds_byte(wc * 32 + fr, fq * 8);
#define PG8_SA(b, h) (((b) * 2 + (h)) * HTB)
#define PG8_SB(b, h) ((4 + (b) * 2 + (h)) * HTB)
#define PG8_STAGE(bufoff, gbase, voff) do { _Pragma("unroll") for (int _i = 0; _i < 2; ++_i) \
        __builtin_amdgcn_global_load_lds((const unsigned*)((const char*)(gbase) + (voff)[_i]), (LAS unsigned*)(lds + (bufoff) + ldsw + _i * 8192), 16, 0, 0); } while (0)
#define PG8_LDA(dst, b, h) do { _Pragma("unroll") for (int m = 0; m < 4; ++m) _Pragma("unroll") for (int k = 0; k < 2; ++k) dst[m][k] = *(const LAS bf16x8*)(lds + PG8_SA(b, h) + aoff + m * 2048 + k * 1024); } while (0)
#define PG8_LDB(dst, b, h) do { _Pragma("unroll") for (int n = 0; n < 2; ++n) _Pragma("unroll") for (int k = 0; k < 2; ++k) dst[n][k] = *(const LAS bf16x8*)(lds + PG8_SB(b, h) + boff + n * 2048 + k * 1024); } while (0)
#define PG8_MMA(ai, bj, At, Bt) do { __builtin_amdgcn_s_setprio(1); _Pragma("unroll") for (int m = 0; m < 4; ++m) _Pragma("unroll") for (int n = 0; n < 2; ++n) _Pragma("unroll") for (int k = 0; k < 2; ++k) \
        acc[ai][bj][m][n] = __builtin_amdgcn_mfma_f32_16x16x32_bf16(Bt[n][k], At[m][k], acc[ai][bj][m][n], 0, 0, 0); __builtin_amdgcn_s_setprio(0); } while (0)
#define PG8_WAIT_V(n) asm volatile("s_waitcnt vmcnt(" #n ")" ::: "memory")
#define PG8_WAIT_L(n) asm volatile("s_waitcnt lgkmcnt(" #n ")" ::: "memory")
#define PG8_BAR __builtin_amdgcn_s_barrier()
#define PG8_SCHED __builtin_amdgcn_sched_barrier(0)
    Unit cur, nxt; int ui = 0;
    if (!S.next(0, cur)) return;
    f32x4 acc[2][2][4][2];
#pragma unroll
    for (int a = 0; a < 2; ++a)
#pragma unroll
        for (int b = 0; b < 2; ++b)
#pragma unroll
            for (int m = 0; m < 4; ++m)
#pragma unroll
                for (int n = 0; n < 2; ++n) acc[a][b][m][n] = (f32x4){0.f, 0.f, 0.f, 0.f};
    bf16x8 At[4][2], B0[2][2], B1[2][2];
    const char* cA = (const char*)g.A + (size_t)cur.pm * tstep; const char* cB = (const char*)g.Bt + (size_t)cur.pn * tstep;
    PG8_STAGE(PG8_SB(0, 0), cB, voffB); PG8_STAGE(PG8_SB(0, 1), cB + hstep, voffB); PG8_STAGE(PG8_SA(0, 0), cA, voffA); PG8_STAGE(PG8_SA(0, 1), cA + hstep, voffA);
    if (wr == 1) PG8_BAR;
    PG8_WAIT_V(2); PG8_BAR;
    PG8_STAGE(PG8_SB(1, 0), cB + kstep, voffB); PG8_STAGE(PG8_SA(1, 0), cA + kstep, voffA); PG8_STAGE(PG8_SB(1, 1), cB + hstep + kstep, voffB);
    PG8_WAIT_V(6); PG8_BAR;
    for (;;) {
        const bool has_next = S.next(ui + 1, nxt);
        const char* nA = has_next ? (const char*)g.A + (size_t)nxt.pm * tstep : cA; const char* nB = has_next ? (const char*)g.Bt + (size_t)nxt.pn * tstep : cB;
        for (int t = 0; t < nt; t += 2) {
            const bool last = (t == nt - 2);
            const char* a1 = cA + (size_t)(t + 1) * kstep;
            const char* a2 = last ? nA : cA + (size_t)(t + 2) * kstep; const char* b2 = last ? nB : cB + (size_t)(t + 2) * kstep;
            const char* a3 = a2 + kstep; const char* b3 = b2 + kstep;
            PG8_LDB(B0, 0, 0); PG8_LDB(B1, 0, 1); PG8_SCHED; PG8_LDA(At, 0, 0); PG8_STAGE(PG8_SA(1, 1), a1 + hstep, voffA);
            PG8_WAIT_V(8); PG8_WAIT_L(0); PG8_BAR; PG8_MMA(0, 0, At, B0); PG8_MMA(0, 1, At, B1); PG8_BAR; PG8_SCHED;
            PG8_LDA(At, 0, 1); PG8_STAGE(PG8_SB(0, 0), b2, voffB); PG8_STAGE(PG8_SB(0, 1), b2 + hstep, voffB); PG8_STAGE(PG8_SA(0, 0), a2, voffA);
            PG8_WAIT_V(8); PG8_WAIT_L(0); PG8_BAR; PG8_MMA(1, 0, At, B0); PG8_MMA(1, 1, At, B1); PG8_BAR; PG8_SCHED;
            PG8_LDB(B0, 1, 0); PG8_LDB(B1, 1, 1); PG8_SCHED; PG8_LDA(At, 1, 0); PG8_STAGE(PG8_SA(0, 1), a2 + hstep, voffA);
            PG8_WAIT_V(8); PG8_WAIT_L(0); PG8_BAR; PG8_MMA(0, 0, At, B0); PG8_MMA(0, 1, At, B1); PG8_BAR; PG8_SCHED;
            PG8_LDA(At, 1, 1); PG8_STAGE(PG8_SB(1, 0), b3, voffB); PG8_STAGE(PG8_SB(1, 1), b3 + hstep, voffB); PG8_STAGE(PG8_SA(1, 0), a3, voffA);
            PG8_WAIT_V(8); PG8_WAIT_L(0); PG8_BAR; PG8_MMA(1, 0, At, B0); PG8_MMA(1, 1, At, B1); PG8_BAR; PG8_SCHED;
            if constexpr (Epi::MIDK) { if (t + 2 == (nt >> 1)) E.mid(acc, cur, wr, wc, fr, fq); }
        }
        if constexpr (ALIGN_EPI) { if (wr == 0) PG8_BAR; }
        E(acc, cur, wr, wc, fr, fq);
        if (!has_next) break;
#pragma unroll
        for (int a = 0; a < 2; ++a)
#pragma unroll
            for (int b = 0; b < 2; ++b)
#pragma unroll
                for (int m = 0; m < 4; ++m)
#pragma unroll
                    for (int n = 0; n < 2; ++n) acc[a][b][m][n] = (f32x4){0.f, 0.f, 0.f, 0.f};
        cur = nxt; cA = nA; cB = nB; ++ui;
        if constexpr (ALIGN_EPI) { if (wr == 1) PG8_BAR; }
    }
    PG8_WAIT_V(0);
    if constexpr (!ALIGN_EPI) { if (wr == 0) PG8_BAR; }
    PG8_BAR;
#undef PG8_SA
#undef PG8_SB
#undef PG8_STAGE
#undef PG8_LDA
#undef PG8_LDB
#undef PG8_MMA
#undef PG8_WAIT_V
#undef PG8_WAIT_L
#undef PG8_BAR
#undef PG8_SCHED
}
}

struct Epi1 {
    static constexpr bool PERM = true, MIDK = false;
    bf16_t *QB, *KB, *VB, *HY, *GT, *XTp; const float* rstd; const float* gate_b; const f32x2* rope; int L;
    __device__ __forceinline__ void operator()(const f32x4 (&acc)[2][2][4][2], const pg8::Unit& u, int wr, int wc, int fr, int fq) const {
        const int pn = u.pn; const int row0 = u.pm * 256 + wr * 64 + fr;
#pragma unroll
        for (int ai = 0; ai < 2; ++ai)
#pragma unroll
            for (int m = 0; m < 4; ++m) {
                const int row = row0 + ai * 128 + m * 16; const float rs = rstd[row]; const int pos = row & (L - 1);
#pragma unroll
                for (int bj = 0; bj < 2; ++bj) {
                    const int lc = bj * 128 + wc * 32 + 8 * fq;
                    f32x4 v0 = acc[ai][bj][m][0] * rs, v1 = acc[ai][bj][m][1] * rs;
                    bf16_t* dst;
                    if (pn < 8) {
                        const int col = (pn & 3) * 256 + lc; const int i0 = (col & 63) >> 1;
                        const f32x2* rp = rope + (size_t)pos * 32 + i0;
                        const f32x2 c0 = rp[0], c1 = rp[1], c2 = rp[2], c3 = rp[3];
                        const float sc = (pn < 4) ? QSCALE : 1.0f;
                        f32x4 w0, w1;
                        w0[0] = (v0[0] * c0[0] - v0[1] * c0[1]) * sc; w0[1] = (v0[1] * c0[0] + v0[0] * c0[1]) * sc;
                        w0[2] = (v0[2] * c1[0] - v0[3] * c1[1]) * sc; w0[3] = (v0[3] * c1[0] + v0[2] * c1[1]) * sc;
                        w1[0] = (v1[0] * c2[0] - v1[1] * c2[1]) * sc; w1[1] = (v1[1] * c2[0] + v1[0] * c2[1]) * sc;
                        w1[2] = (v1[2] * c3[0] - v1[3] * c3[1]) * sc; w1[3] = (v1[3] * c3[0] + v1[2] * c3[1]) * sc;
                        v0 = w0; v1 = w1;
                        dst = ((pn < 4) ? QB : KB) + (size_t)row * 1024 + col;
                    } else if (pn < 12) {
                        dst = VB + (size_t)row * 1024 + (pn - 8) * 256 + lc;
                    } else if (pn < 16) {
                        dst = HY + (size_t)row * 3072 + (pn - 12) * 256 + lc;
                    } else if (pn < 24) {
                        bf16_t* xt = XTp + (size_t)((pn - 16) * 256 + lc) * CH + row;
#pragma unroll
                        for (int e = 0; e < 4; ++e) { xt[(size_t)e * CH] = (bf16_t)f2bf(v0[e]); xt[(size_t)(4 + e) * CH] = (bf16_t)f2bf(v1[e]); }
                        continue;
                    } else {
                        const int gc = (pn - 24) * 256 + lc;
                        const f32x4 b0 = *(const f32x4*)(gate_b + gc), b1 = *(const f32x4*)(gate_b + gc + 4);
#pragma unroll
                        for (int e = 0; e < 4; ++e) { v0[e] = __builtin_amdgcn_rcpf(1.0f + __expf(-(v0[e] + b0[e]))); v1[e] = __builtin_amdgcn_rcpf(1.0f + __expf(-(v1[e] + b1[e]))); }
                        dst = GT + (size_t)row * 4096 + gc;
                    }
                    u32x4 w; w.x = cvt_pk_bf16(v0[0], v0[1]); w.y = cvt_pk_bf16(v0[2], v0[3]); w.z = cvt_pk_bf16(v1[0], v1[1]); w.w = cvt_pk_bf16(v1[2], v1[3]);
                    *(u32x4*)dst = w;
                }
            }
    }
};
template <int PASS> struct Epi2 {
    static constexpr bool PERM = true, MIDK = false;
    const bf16_t* GT; bf16_t* T1; bf16_t* MG;
    __device__ __forceinline__ void operator()(const f32x4 (&acc)[2][2][4][2], const pg8::Unit& u, int wr, int wc, int fr, int fq) const {
        const int row0 = u.pm * 256 + wr * 64 + fr;
#pragma unroll
        for (int ai = 0; ai < 2; ++ai)
#pragma unroll
            for (int m = 0; m < 4; ++m) {
                const int row = row0 + ai * 128 + m * 16;
#pragma unroll
                for (int bj = 0; bj < 2; ++bj) {
                    const int col = u.pn * 256 + bj * 128 + wc * 32 + 8 * fq;
                    const u32x4 gw = *(const u32x4*)(GT + (size_t)row * 4096 + PASS * 2048 + col);
                    f32x4 v0 = acc[ai][bj][m][0], v1 = acc[ai][bj][m][1];
                    v0[0] *= bflo(gw.x); v0[1] *= bfhi(gw.x); v0[2] *= bflo(gw.y); v0[3] *= bfhi(gw.y);
                    v1[0] *= bflo(gw.z); v1[1] *= bfhi(gw.z); v1[2] *= bflo(gw.w); v1[3] *= bfhi(gw.w);
                    if (PASS == 1) {
                        const u32x4 tw = *(const u32x4*)(T1 + (size_t)row * 2048 + col);
                        v0[0] += bflo(tw.x); v0[1] += bfhi(tw.x); v0[2] += bflo(tw.y); v0[3] += bfhi(tw.y);
                        v1[0] += bflo(tw.z); v1[1] += bfhi(tw.z); v1[2] += bflo(tw.w); v1[3] += bfhi(tw.w);
                    }
                    u32x4 w; w.x = cvt_pk_bf16(v0[0], v0[1]); w.y = cvt_pk_bf16(v0[2], v0[3]); w.z = cvt_pk_bf16(v1[0], v1[1]); w.w = cvt_pk_bf16(v1[2], v1[3]);
                    *(u32x4*)((PASS == 0 ? T1 : MG) + (size_t)row * 2048 + col) = w;
                }
            }
    }
};
struct Epi2M {
    static constexpr bool PERM = true, MIDK = true;
    const bf16_t* GT; bf16_t* MG;
    __device__ __forceinline__ void mid(f32x4 (&acc)[2][2][4][2], const pg8::Unit& u, int wr, int wc, int fr, int fq) const {
        int row0 = u.pm * 256 + wr * 64 + fr; asm volatile("" : "+v"(row0));
#pragma unroll
        for (int ai = 0; ai < 2; ++ai)
#pragma unroll
            for (int m = 0; m < 4; ++m) {
                const int row = row0 + ai * 128 + m * 16;
#pragma unroll
                for (int bj = 0; bj < 2; ++bj) {
                    const int col = u.pn * 256 + bj * 128 + wc * 32 + 8 * fq;
                    const u32x4 a = *(const u32x4*)(GT + (size_t)row * 4096 + col), b = *(const u32x4*)(GT + (size_t)row * 4096 + 2048 + col);
                    acc[ai][bj][m][0][0] *= bflo(a.x) * __builtin_amdgcn_rcpf(bflo(b.x)); acc[ai][bj][m][0][1] *= bfhi(a.x) * __builtin_amdgcn_rcpf(bfhi(b.x));
                    acc[ai][bj][m][0][2] *= bflo(a.y) * __builtin_amdgcn_rcpf(bflo(b.y)); acc[ai][bj][m][0][3] *= bfhi(a.y) * __builtin_amdgcn_rcpf(bfhi(b.y));
                    acc[ai][bj][m][1][0] *= bflo(a.z) * __builtin_amdgcn_rcpf(bflo(b.z)); acc[ai][bj][m][1][1] *= bfhi(a.z) * __builtin_amdgcn_rcpf(bfhi(b.z));
                    acc[ai][bj][m][1][2] *= bflo(a.w) * __builtin_amdgcn_rcpf(bflo(b.w)); acc[ai][bj][m][1][3] *= bfhi(a.w) * __builtin_amdgcn_rcpf(bfhi(b.w));
                    __builtin_amdgcn_sched_barrier(0);
                }
            }
    }
    __device__ __forceinline__ void operator()(const f32x4 (&acc)[2][2][4][2], const pg8::Unit& u, int wr, int wc, int fr, int fq) const {
        const int row0 = u.pm * 256 + wr * 64 + fr;
#pragma unroll
        for (int ai = 0; ai < 2; ++ai)
#pragma unroll
            for (int m = 0; m < 4; ++m) {
                const int row = row0 + ai * 128 + m * 16;
#pragma unroll
                for (int bj = 0; bj < 2; ++bj) {
                    const int col = u.pn * 256 + bj * 128 + wc * 32 + 8 * fq;
                    const u32x4 gw = *(const u32x4*)(GT + (size_t)row * 4096 + 2048 + col);
                    f32x4 v0 = acc[ai][bj][m][0], v1 = acc[ai][bj][m][1];
                    v0[0] *= bflo(gw.x); v0[1] *= bfhi(gw.x); v0[2] *= bflo(gw.y); v0[3] *= bfhi(gw.y);
                    v1[0] *= bflo(gw.z); v1[1] *= bfhi(gw.z); v1[2] *= bflo(gw.w); v1[3] *= bfhi(gw.w);
                    u32x4 w; w.x = cvt_pk_bf16(v0[0], v0[1]); w.y = cvt_pk_bf16(v0[2], v0[3]); w.z = cvt_pk_bf16(v1[0], v1[1]); w.w = cvt_pk_bf16(v1[2], v1[3]);
                    *(u32x4*)(MG + (size_t)row * 2048 + col) = w;
                }
            }
    }
};
template <bool WB> struct EpiRes {
    static constexpr bool PERM = false, MIDK = false;
    const float* base; float* out; bf16_t* ob; float* part;
    __device__ __forceinline__ void operator()(const f32x4 (&acc)[2][2][4][2], const pg8::Unit& u, int wr, int wc, int fr, int fq) const {
        const int row0 = u.pm * 256 + wr * 64 + fr;
#pragma unroll
        for (int ai = 0; ai < 2; ++ai)
#pragma unroll
            for (int m = 0; m < 4; ++m) {
                const int row = row0 + ai * 128 + m * 16; float ss = 0.f;
#pragma unroll
                for (int bj = 0; bj < 2; ++bj)
#pragma unroll
                    for (int n = 0; n < 2; ++n) {
                        const size_t off = (size_t)row * 2048 + u.pn * 256 + bj * 128 + wc * 32 + n * 16 + 4 * fq;
                        const f32x4 v = *(const f32x4*)(base + off) + acc[ai][bj][m][n];
                        *(f32x4*)(out + off) = v;
                        if (WB) { u32x2 w; w.x = cvt_pk_bf16(v[0], v[1]); w.y = cvt_pk_bf16(v[2], v[3]); *(u32x2*)(ob + off) = w; }
                        ss += (v[0] * v[0] + v[1] * v[1]) + (v[2] * v[2] + v[3] * v[3]);
                    }
                { const int ln = fr + 16 * fq; ss += lane_xor_get(ss, ln, 16); ss += lane_xor_get(ss, ln, 32); }
                if (fq == 0) part[(size_t)row * 32 + u.pn * 4 + wc] = ss;
            }
    }
};
struct EpiResB {
    static constexpr bool PERM = true, MIDK = false;
    const bf16_t* base; bf16_t* ob; float* part;
    __device__ __forceinline__ void operator()(const f32x4 (&acc)[2][2][4][2], const pg8::Unit& u, int wr, int wc, int fr, int fq) const {
        const int row0 = u.pm * 256 + wr * 64 + fr;
#pragma unroll
        for (int ai = 0; ai < 2; ++ai)
#pragma unroll
            for (int m = 0; m < 4; ++m) {
                const int row = row0 + ai * 128 + m * 16; float ss = 0.f;
#pragma unroll
                for (int bj = 0; bj < 2; ++bj) {
                    const size_t off = (size_t)row * 2048 + u.pn * 256 + bj * 128 + wc * 32 + 8 * fq;
                    const u32x4 bw = *(const u32x4*)(base + off);
                    f32x4 v0 = acc[ai][bj][m][0], v1 = acc[ai][bj][m][1];
                    v0[0] += bflo(bw.x); v0[1] += bfhi(bw.x); v0[2] += bflo(bw.y); v0[3] += bfhi(bw.y);
                    v1[0] += bflo(bw.z); v1[1] += bfhi(bw.z); v1[2] += bflo(bw.w); v1[3] += bfhi(bw.w);
                    ss += ((v0[0] * v0[0] + v0[1] * v0[1]) + (v0[2] * v0[2] + v0[3] * v0[3])) + ((v1[0] * v1[0] + v1[1] * v1[1]) + (v1[2] * v1[2] + v1[3] * v1[3]));
                    u32x4 w; w.x = cvt_pk_bf16(v0[0], v0[1]); w.y = cvt_pk_bf16(v0[2], v0[3]); w.z = cvt_pk_bf16(v1[0], v1[1]); w.w = cvt_pk_bf16(v1[2], v1[3]);
                    *(u32x4*)(ob + off) = w;
                }
                { const int ln = fr + 16 * fq; ss += lane_xor_get(ss, ln, 16); ss += lane_xor_get(ss, ln, 32); }
                if (fq == 0) part[(size_t)row * 32 + u.pn * 4 + wc] = ss;
            }
    }
};
struct Epi4 {
    static constexpr bool PERM = true, MIDK = false;
    bf16_t* UP; const float* part;
    __device__ __forceinline__ void operator()(const f32x4 (&acc)[2][2][4][2], const pg8::Unit& u, int wr, int wc, int fr, int fq) const {
        const int row0 = u.pm * 256 + wr * 64 + fr;
#pragma unroll
        for (int ai = 0; ai < 2; ++ai)
#pragma unroll
            for (int m = 0; m < 4; ++m) {
                const int row = row0 + ai * 128 + m * 16;
                const f32x4 pa = *(const f32x4*)(part + (size_t)row * 32 + 8 * fq), pb = *(const f32x4*)(part + (size_t)row * 32 + 8 * fq + 4);
                float s = ((pa[0] + pa[1]) + (pa[2] + pa[3])) + ((pb[0] + pb[1]) + (pb[2] + pb[3]));
                { const int ln = fr + 16 * fq; s += lane_xor_get(s, ln, 16); s += lane_xor_get(s, ln, 32); }
                const float rs = rsqrtf(s * (1.0f / 2048.0f) + EPS);
#pragma unroll
                for (int bj = 0; bj < 2; ++bj) {
                    const int col = u.pn * 256 + bj * 128 + wc * 32 + 8 * fq;
                    const f32x4 v0 = acc[ai][bj][m][0] * rs, v1 = acc[ai][bj][m][1] * rs;
                    u32x4 w; w.x = cvt_pk_bf16(v0[0], v0[1]); w.y = cvt_pk_bf16(v0[2], v0[3]); w.z = cvt_pk_bf16(v1[0], v1[1]); w.w = cvt_pk_bf16(v1[2], v1[3]);
                    *(u32x4*)(UP + (size_t)row * UPW + col) = w;
                }
            }
    }
};

__device__ __forceinline__ void transpose_item(const float* W, int K, int N, bf16_t* WT, const float* g, bool ropeperm, LAS float* scr, int item, int lane, int ldk = 0, int koff = 0) {
    if (ldk == 0) ldk = K;
    const int nblk = N / 64, kb = item / nblk, nb = item % nblk, k0 = 64 * kb, n0 = 64 * nb;
    int sn = n0 + lane;
    if (ropeperm && sn < 2048) sn = (sn & ~63) + ((sn & 63) >> 1) + 32 * (sn & 1);
    float wv[64];
#pragma unroll
    for (int kk = 0; kk < 64; ++kk) wv[kk] = W[(size_t)(k0 + kk) * N + sn];
    if (g) {
#pragma unroll
        for (int kk = 0; kk < 64; kk += 4) { const f32x4 gg = *(const f32x4*)(g + k0 + kk); wv[kk] *= gg[0]; wv[kk + 1] *= gg[1]; wv[kk + 2] *= gg[2]; wv[kk + 3] *= gg[3]; }
    }
#pragma unroll
    for (int kk = 0; kk < 64; ++kk) scr[kk * 65 + lane] = wv[kk];
    asm volatile("s_waitcnt lgkmcnt(0)" ::: "memory");
    const int c = lane & 7;
#pragma unroll
    for (int j = 0; j < 8; ++j) { const int n = (lane >> 3) + 8 * j; const LAS float* s = scr + (8 * c) * 65 + n;
        u32x4 o; o.x = pk2(s[0 * 65], s[1 * 65]); o.y = pk2(s[2 * 65], s[3 * 65]); o.z = pk2(s[4 * 65], s[5 * 65]); o.w = pk2(s[6 * 65], s[7 * 65]);
        *(u32x4*)(WT + (size_t)(n0 + n) * ldk + koff + k0 + 8 * c) = o; }
    asm volatile("s_waitcnt lgkmcnt(0)" ::: "memory");
}

constexpr int AT_KB = 64 * 272, AT_VB = 64 * 320, AT_BUF = AT_KB + AT_VB;
__device__ __forceinline__ void attn_stage(LAS unsigned char* lds, int bufoff, const bf16_t* Kg, const bf16_t* Vg, int wid, int lane) {
#pragma unroll
    for (int i = 0; i < 5; ++i) {
        const int pc = wid + 8 * i;
        if (pc < 37) {
            const bool isk = pc < 17; const int o = (isk ? pc : pc - 17) * 1024 + lane * 16;
            const int pitch = isk ? 272 : 320; const int row = o / pitch; int ch = (o - row * pitch) >> 4; if (ch > 15) ch = 0;
            const bf16_t* src = (isk ? Kg : Vg) + (unsigned)(row * 1024 + ch * 8);
            __builtin_amdgcn_global_load_lds((const unsigned*)src, (LAS unsigned*)(lds + bufoff + (isk ? 0 : AT_KB) + (isk ? pc : pc - 17) * 1024), 16, 0, 0);
        }
    }
}
__device__ __forceinline__ s16x4 vtr(const LAS unsigned char* p) { typedef short v4i16_t __attribute__((ext_vector_type(4))); return __builtin_bit_cast(s16x4, __builtin_amdgcn_ds_read_tr16_b64_v4i16((LAS v4i16_t*)p)); }

__device__ __forceinline__ void softmax_step(f32x16& s, float& m, float& l, f32x16 (&o)[4], bf16x8 (&pk)[2]) {
    float a = fmaxf(fmaxf(s[0], s[1]), s[2]), b = fmaxf(fmaxf(s[3], s[4]), s[5]);
    a = fmaxf(fmaxf(a, s[6]), s[7]); b = fmaxf(fmaxf(b, s[8]), s[9]);
    a = fmaxf(fmaxf(a, s[10]), s[11]); b = fmaxf(fmaxf(b, s[12]), s[13]);
    a = fmaxf(fmaxf(a, s[14]), s[15]);
    const float mx = swap_max(fmaxf(a, b));
    if (__any(mx > m + 8.0f)) {
        const float mn = fmaxf(m, mx);
        const float alpha = __builtin_amdgcn_exp2f(m - mn);
#pragma unroll
        for (int d = 0; d < 4; ++d)
#pragma unroll
            for (int r = 0; r < 16; ++r) o[d][r] *= alpha;
        l *= alpha; m = mn;
    }
    float sum = 0.f;
#pragma unroll
    for (int r = 0; r < 16; ++r) { s[r] = __builtin_amdgcn_exp2f(s[r] - m); sum += s[r]; }
    l += sum;
#pragma unroll
    for (int ks = 0; ks < 2; ++ks) {
        u32x4 w; w.x = cvt_pk_bf16(s[8 * ks + 0], s[8 * ks + 1]); w.y = cvt_pk_bf16(s[8 * ks + 2], s[8 * ks + 3]); w.z = cvt_pk_bf16(s[8 * ks + 4], s[8 * ks + 5]); w.w = cvt_pk_bf16(s[8 * ks + 6], s[8 * ks + 7]);
        pk[ks] = __builtin_bit_cast(bf16x8, w);
    }
}

__device__ __forceinline__ void softmax_step64(f32x16& sa, f32x16& sb, float& m, float& l, f32x16 (&o)[4], bf16x8 (&pk)[4]) {
    float a = fmaxf(fmaxf(sa[0], sa[1]), sa[2]), b = fmaxf(fmaxf(sb[0], sb[1]), sb[2]);
#pragma unroll
    for (int r = 3; r < 15; r += 2) { a = fmaxf(fmaxf(a, sa[r]), sa[r + 1]); b = fmaxf(fmaxf(b, sb[r]), sb[r + 1]); }
    a = fmaxf(a, sa[15]); b = fmaxf(b, sb[15]);
    const float mx = swap_max(fmaxf(a, b));
    if (__any(mx > m + 8.0f)) {
        const float mn = fmaxf(m, mx);
        const float alpha = __builtin_amdgcn_exp2f(m - mn);
#pragma unroll
        for (int d = 0; d < 4; ++d)
#pragma unroll
            for (int r = 0; r < 16; ++r) o[d][r] *= alpha;
        l *= alpha; m = mn;
    }
    float sum = 0.f;
#pragma unroll
    for (int r = 0; r < 16; ++r) { sa[r] = __builtin_amdgcn_exp2f(sa[r] - m); sb[r] = __builtin_amdgcn_exp2f(sb[r] - m); sum += sa[r] + sb[r]; }
    l += sum;
#pragma unroll
    for (int ks = 0; ks < 2; ++ks) {
        u32x4 w; w.x = cvt_pk_bf16(sa[8 * ks + 0], sa[8 * ks + 1]); w.y = cvt_pk_bf16(sa[8 * ks + 2], sa[8 * ks + 3]); w.z = cvt_pk_bf16(sa[8 * ks + 4], sa[8 * ks + 5]); w.w = cvt_pk_bf16(sa[8 * ks + 6], sa[8 * ks + 7]);
        pk[ks] = __builtin_bit_cast(bf16x8, w);
        u32x4 v; v.x = cvt_pk_bf16(sb[8 * ks + 0], sb[8 * ks + 1]); v.y = cvt_pk_bf16(sb[8 * ks + 2], sb[8 * ks + 3]); v.z = cvt_pk_bf16(sb[8 * ks + 4], sb[8 * ks + 5]); v.w = cvt_pk_bf16(sb[8 * ks + 6], sb[8 * ks + 7]);
        pk[2 + ks] = __builtin_bit_cast(bf16x8, v);
    }
}
__device__ __forceinline__ void attn_item(LAS unsigned char* lds, const bf16_t* QB, const bf16_t* KB, const bf16_t* VB, bf16_t* AT, int tb, int h, int qb, int L, float lam, const float* subln) {
    int tid = threadIdx.x; asm volatile("" : "+v"(tid));
    const int lane = tid & 63, r32 = lane & 31, hi = lane >> 5; const int wid = __builtin_amdgcn_readfirstlane(tid >> 6);
    const int tokq = tb + qb * 256 + wid * 32 + r32;
    LAS unsigned char* qs = lds + 2 * AT_BUF + wid * 8704 + r32 * 272 + hi * 16;
#pragma unroll
    for (int mp = 0; mp < 2; ++mp)
#pragma unroll
        for (int d0 = 0; d0 < 4; ++d0) *(LAS bf16x8*)(qs + mp * 128 + d0 * 32) = *(const bf16x8*)(QB + (size_t)tokq * 1024 + h * 128 + mp * 64 + d0 * 16 + hi * 8);
    f32x16 o0[4], o1[4];
#pragma unroll
    for (int d = 0; d < 4; ++d)
#pragma unroll
        for (int r = 0; r < 16; ++r) { o0[d][r] = 0.f; o1[d][r] = 0.f; }
    float m0 = -INFINITY, m1 = -INFINITY, l0 = 0.f, l1 = 0.f;
    const bf16_t* Kh = KB + (size_t)tb * 1024 + h * 128; const bf16_t* Vh = VB + (size_t)tb * 1024 + h * 128;
    const int NT = L / 64;
    const int qd = (lane & 15) >> 2, pp = lane & 3, blk = (lane >> 4) & 1;
    const int koff = r32 * 272 + hi * 16;
    const int voff = AT_KB + (4 * hi + qd) * 320 + (16 * blk + 4 * pp) * 2;
    bf16x8 pk0[4], pk1[4];
#define AT_S64(cbuf, MP, MM, LL, OO, PK) do { \
        const LAS unsigned char* kp = lds + (cbuf) + koff + (MP) * 128; \
        bf16x8 qa[4], ka[4], kb[4]; \
        f32x16 sa, sb; _Pragma("unroll") for (int r = 0; r < 16; ++r) { sa[r] = 0.f; sb[r] = 0.f; } \
        _Pragma("unroll") for (int d0 = 0; d0 < 4; ++d0) { qa[d0] = *(const LAS bf16x8*)(qs + (MP) * 128 + d0 * 32); ka[d0] = *(const LAS bf16x8*)(kp + d0 * 32); kb[d0] = *(const LAS bf16x8*)(kp + 32 * 272 + d0 * 32); } \
        __builtin_amdgcn_sched_barrier(0); \
        _Pragma("unroll") for (int d0 = 0; d0 < 4; ++d0) { \
            sa = __builtin_amdgcn_mfma_f32_32x32x16_bf16(ka[d0], qa[d0], sa, 0, 0, 0); \
            sb = __builtin_amdgcn_mfma_f32_32x32x16_bf16(kb[d0], qa[d0], sb, 0, 0, 0); } \
        __builtin_amdgcn_sched_barrier(0); \
        softmax_step64(sa, sb, MM, LL, OO, PK); \
        __builtin_amdgcn_sched_barrier(0); } while (0)
#define AT_PV64(cbuf, sub) do { \
        const LAS unsigned char* vp = lds + (cbuf) + voff + (sub) * 32 * 320; \
        _Pragma("unroll") for (int hh = 0; hh < 2; ++hh) { \
            s16x4 vlo[4], vhi[4]; \
            _Pragma("unroll") for (int i2 = 0; i2 < 4; ++i2) { const int i = 4 * hh + i2; vlo[i2] = vtr(vp + (i & 1) * 16 * 320 + (i >> 1) * 64); vhi[i2] = vtr(vp + (i & 1) * 16 * 320 + 8 * 320 + (i >> 1) * 64); } \
            __builtin_amdgcn_sched_barrier(0); \
            _Pragma("unroll") for (int i2 = 0; i2 < 4; ++i2) { const int i = 4 * hh + i2; \
                const bf16x8 vf = (bf16x8){vlo[i2][0], vlo[i2][1], vlo[i2][2], vlo[i2][3], vhi[i2][0], vhi[i2][1], vhi[i2][2], vhi[i2][3]}; \
                o0[i >> 1] = __builtin_amdgcn_mfma_f32_32x32x16_bf16(vf, pk0[2 * (sub) + (i & 1)], o0[i >> 1], 0, 0, 0); \
                o1[i >> 1] = __builtin_amdgcn_mfma_f32_32x32x16_bf16(vf, pk1[2 * (sub) + (i & 1)], o1[i >> 1], 0, 0, 0); } \
            __builtin_amdgcn_sched_barrier(0); } } while (0)
    attn_stage(lds, 0, Kh, Vh, wid, lane);
    asm volatile("s_waitcnt vmcnt(0)" ::: "memory"); __syncthreads();
    for (int t = 0; t < NT; ++t) {
        const int cb = (t & 1) * AT_BUF;
        if (t + 1 < NT) attn_stage(lds, AT_BUF - cb, Kh + (size_t)(t + 1) * 64 * 1024, Vh + (size_t)(t + 1) * 64 * 1024, wid, lane);
        AT_S64(cb, 0, m0, l0, o0, pk0);
        AT_S64(cb, 1, m1, l1, o1, pk1);
        AT_PV64(cb, 0);
        AT_PV64(cb, 1);
        asm volatile("s_waitcnt vmcnt(0)" ::: "memory"); __syncthreads();
    }
#undef AT_S64
#undef AT_PV64
    int tq2 = tb + qb * 256 + wid * 32 + r32; asm volatile("" : "+v"(tq2));
    l0 = swap_add(l0); l1 = swap_add(l1);
    const float i0 = 1.0f / l0, i1 = __uint_as_float((unsigned)__builtin_amdgcn_readfirstlane((int)__float_as_uint(lam))) / l1;
    float ss = 0.f;
#pragma unroll
    for (int d = 0; d < 4; ++d)
#pragma unroll
        for (int r = 0; r < 16; ++r) { const float a = o0[d][r] * i0 - o1[d][r] * i1; o0[d][r] = a; ss += a * a; }
    ss = swap_add(ss);
    const float rs = rsqrtf(ss * (1.0f / 128.0f) + EPS) * (1.0f - LAMBDA_INIT);
    bf16_t* orow = AT + (size_t)tq2 * 2048 + h * 128;
#pragma unroll
    for (int d = 0; d < 4; ++d)
#pragma unroll
        for (int g = 0; g < 4; ++g) {
            const int dd = 32 * d + 8 * g + 4 * hi;
            const f32x4 gg = *(const f32x4*)(subln + dd);
            u32x2 w; w.x = cvt_pk_bf16(o0[d][4 * g + 0] * rs * gg[0], o0[d][4 * g + 1] * rs * gg[1]); w.y = cvt_pk_bf16(o0[d][4 * g + 2] * rs * gg[2], o0[d][4 * g + 3] * rs * gg[3]);
            *(u32x2*)(orow + dd) = w;
        }
}

constexpr int HY_F1 = 32832, HY_U = 66048;
__device__ __forceinline__ void hyena_item(LAS unsigned char* lds, const bf16_t* FILT  , const bf16_t* XTp, const float* cw, const float* cb, bf16_t* YT, int c, int L) {
    int tid = threadIdx.x; asm volatile("" : "+v"(tid));
    const int lane = tid & 63, r32 = lane & 31, hi = lane >> 5; const int wid = __builtin_amdgcn_readfirstlane(tid >> 6);
    const int NB = L >> 5, B = CH / L, G = 32 / B, gsh = (B == 2) ? 4 : 3, APAD = 4 * G, NBP = NB + 8 * G + 4, QP = NBP >> 2, BS = 16 * QP + 8;
    __syncthreads();
    {
        const int npc = (2 * L * 2) / 16;
        const u32x4* src = (const u32x4*)(FILT + (size_t)c * 4 * L);
        for (int q = tid; q < 2 * npc; q += 512) {
            const int cp = q >= npc; const int qq = cp ? q - npc : q;
            *(LAS u32x4*)(lds + (cp ? HY_F1 : 0) + qq * 16) = src[q];
        }
        const bf16_t* x1t = XTp + (size_t)c * CH; const bf16_t* hvt = XTp + (size_t)(1024 + c) * CH;
        const float wx0 = cw[1024 + c], wx1 = cw[3072 + 1024 + c], wx2 = cw[6144 + 1024 + c], bx = cb[1024 + c];
        const float wh0 = cw[2048 + c], wh1 = cw[3072 + 2048 + c], wh2 = cw[6144 + 2048 + c], bh = cb[2048 + c];
        for (int q = tid; q < CH / 8; q += 512) {
            const int tk = q * 8, b = tk / L, pos = tk - b * L, a = pos >> 5, r = (pos >> 3) & 3;
            const u32x4 xw = *(const u32x4*)(x1t + tk), hw = *(const u32x4*)(hvt + tk);
            const float px = pos > 0 ? bf2f(x1t[tk - 1]) : 0.f, ph = pos > 0 ? bf2f(hvt[tk - 1]) : 0.f;
            const float nx = pos + 8 < L ? bf2f(x1t[tk + 8]) : 0.f, nh = pos + 8 < L ? bf2f(hvt[tk + 8]) : 0.f;
            float xs[10], hs[10];
            xs[0] = px; xs[1] = bflo(xw.x); xs[2] = bfhi(xw.x); xs[3] = bflo(xw.y); xs[4] = bfhi(xw.y); xs[5] = bflo(xw.z); xs[6] = bfhi(xw.z); xs[7] = bflo(xw.w); xs[8] = bfhi(xw.w); xs[9] = nx;
            hs[0] = ph; hs[1] = bflo(hw.x); hs[2] = bfhi(hw.x); hs[3] = bflo(hw.y); hs[4] = bfhi(hw.y); hs[5] = bflo(hw.z); hs[6] = bfhi(hw.z); hs[7] = bflo(hw.w); hs[8] = bfhi(hw.w); hs[9] = nh;
            float u[8];
#pragma unroll
            for (int e = 0; e < 8; ++e) u[e] = (wx0 * xs[e] + wx1 * xs[e + 1] + wx2 * xs[e + 2] + bx) * (wh0 * hs[e] + wh1 * hs[e + 1] + wh2 * hs[e + 2] + bh);
            u32x4 uw; uw.x = cvt_pk_bf16(u[0], u[1]); uw.y = cvt_pk_bf16(u[2], u[3]); uw.z = cvt_pk_bf16(u[4], u[5]); uw.w = cvt_pk_bf16(u[6], u[7]);
            { const int idx = APAD + a; *(LAS u32x4*)(lds + HY_U + (b * BS + (r * 4 + (idx & 3)) * QP + (idx >> 2)) * 16) = uw; }
        }
        const int npad = 8 * G + 4, nz = 4 * B * npad;
        for (int z = tid; z < nz; z += 512) {
            const int plane = z / npad, w_ = z - plane * npad; const int idx = (w_ < APAD) ? w_ : NB + w_;
            *(LAS u32x4*)(lds + HY_U + ((plane >> 2) * BS + ((plane & 3) * 4 + (idx & 3)) * QP + (idx >> 2)) * 16) = zero4();
        }
    }
    __syncthreads();
    {
    const int wq = wid & 3, half = wid >> 2;
    f32x16 acc0, acc1, acc2, acc3;
#pragma unroll
    for (int r = 0; r < 16; ++r) { acc0[r] = 0.f; acc1[r] = 0.f; acc2[r] = 0.f; acc3[r] = 0.f; }
    const int bn = r32 >> gsh, iblk = r32 & (G - 1);
    const int Ib = G * 4 * wq;
    const int dlo_all = Ib - NB + 1, dhi_all = Ib + 4 * G - 1, dmid = dlo_all + ((dhi_all - dlo_all + 1) >> 1);
    const int dlo = half ? dmid : dlo_all, dhi = half ? dhi_all : dmid - 1;
#define HY_LOADA(P, DL) do { \
        _Pragma("unroll") for (int kh = 0; kh < 2; ++kh) { \
            const int x0 = L - 32 * (DL) + 16 * kh + 8 * hi - r32; const int cp = x0 & 1; const int xe = x0 - cp; \
            const LAS unsigned* fp = (const LAS unsigned*)(lds + (cp ? HY_F1 : 0)) + (xe >> 1); \
            P##a[kh].x = fp[0]; P##a[kh].y = fp[1]; P##a[kh].z = fp[2]; P##a[kh].w = fp[3]; } } while (0)
#define HY_LOADB(P, DL) do { \
        const int ix = Ib + APAD - (DL); \
        _Pragma("unroll") for (int kh = 0; kh < 2; ++kh) \
            P##b[kh] = *(const LAS u32x4*)(lds + HY_U + (bn * BS + ((2 * kh + hi) * 4 + (ix & 3)) * QP + (ix >> 2) + iblk) * 16); } while (0)
#define HY_CL(x) ((x) <= dhi ? (x) : dhi)
#define HY_LD(P, DL) do { const int d_ = HY_CL(DL); HY_LOADA(P, d_); HY_LOADB(P, d_); } while (0)
#define HY_MMA4(P, Q1, Q2, Q3) do { \
        _Pragma("unroll") for (int kh = 0; kh < 2; ++kh) { \
            acc0 = __builtin_amdgcn_mfma_f32_32x32x16_bf16(__builtin_bit_cast(bf16x8, P##a[kh]), __builtin_bit_cast(bf16x8, P##b[kh]), acc0, 0, 0, 0); \
            acc1 = __builtin_amdgcn_mfma_f32_32x32x16_bf16(__builtin_bit_cast(bf16x8, P##a[kh]), __builtin_bit_cast(bf16x8, Q1##b[kh]), acc1, 0, 0, 0); \
            acc2 = __builtin_amdgcn_mfma_f32_32x32x16_bf16(__builtin_bit_cast(bf16x8, P##a[kh]), __builtin_bit_cast(bf16x8, Q2##b[kh]), acc2, 0, 0, 0); \
            acc3 = __builtin_amdgcn_mfma_f32_32x32x16_bf16(__builtin_bit_cast(bf16x8, P##a[kh]), __builtin_bit_cast(bf16x8, Q3##b[kh]), acc3, 0, 0, 0); } } while (0)
#define HY_SB() __builtin_amdgcn_sched_barrier(0)
    u32x4 P0a[2], P0b[2], P1a[2], P1b[2], P2a[2], P2b[2], P3a[2], P3b[2], P4a[2], P4b[2];
    HY_LOADB(P4, dlo - 1); HY_LOADB(P3, dlo - 2); HY_LOADB(P2, dlo - 3);
    HY_LD(P0, dlo);
    int dl = dlo;
    for (; dl + 4 <= dhi; dl += 5) {
        HY_SB(); HY_LD(P1, dl + 1); HY_SB(); HY_MMA4(P0, P4, P3, P2);
        HY_SB(); HY_LD(P2, dl + 2); HY_SB(); HY_MMA4(P1, P0, P4, P3);
        HY_SB(); HY_LD(P3, dl + 3); HY_SB(); HY_MMA4(P2, P1, P0, P4);
        HY_SB(); HY_LD(P4, dl + 4); HY_SB(); HY_MMA4(P3, P2, P1, P0);
        HY_SB(); HY_LD(P0, dl + 5); HY_SB(); HY_MMA4(P4, P3, P2, P1);
    }
    HY_SB();
    if (dl <= dhi)     { HY_LD(P1, dl + 1); HY_MMA4(P0, P4, P3, P2); }
    if (dl + 1 <= dhi) { HY_LD(P2, dl + 2); HY_MMA4(P1, P0, P4, P3); }
    if (dl + 2 <= dhi) { HY_LD(P3, dl + 3); HY_MMA4(P2, P1, P0, P4); }
    if (dl + 3 <= dhi) { HY_MMA4(P3, P2, P1, P0); }
#undef HY_LOADA
#undef HY_LOADB
#undef HY_CL
#undef HY_LD
#undef HY_MMA4
#undef HY_SB
    __syncthreads();
    LAS float* stash = (LAS float*)lds + (wq * 64) * 64 + lane;
    if (half) {
#pragma unroll
        for (int r = 0; r < 16; ++r) { stash[(r) * 64] = acc0[r]; stash[(16 + r) * 64] = acc1[r]; stash[(32 + r) * 64] = acc2[r]; stash[(48 + r) * 64] = acc3[r]; }
    }
    __syncthreads();
    if (!half) {
#pragma unroll
        for (int r = 0; r < 16; ++r) { acc0[r] += stash[(r) * 64]; acc1[r] += stash[(16 + r) * 64]; acc2[r] += stash[(32 + r) * 64]; acc3[r] += stash[(48 + r) * 64]; }
        bf16_t* yb = YT + (size_t)c * CH + bn * L + 32 * (Ib + 4 * iblk) + 4 * hi;
#pragma unroll
        for (int g = 0; g < 4; ++g) {
            u32x2 w;
            w.x = cvt_pk_bf16(acc0[4 * g + 0], acc0[4 * g + 1]); w.y = cvt_pk_bf16(acc0[4 * g + 2], acc0[4 * g + 3]); *(u32x2*)(yb + 8 * g) = w;
            w.x = cvt_pk_bf16(acc1[4 * g + 0], acc1[4 * g + 1]); w.y = cvt_pk_bf16(acc1[4 * g + 2], acc1[4 * g + 3]); *(u32x2*)(yb + 32 + 8 * g) = w;
            w.x = cvt_pk_bf16(acc2[4 * g + 0], acc2[4 * g + 1]); w.y = cvt_pk_bf16(acc2[4 * g + 2], acc2[4 * g + 3]); *(u32x2*)(yb + 64 + 8 * g) = w;
            w.x = cvt_pk_bf16(acc3[4 * g + 0], acc3[4 * g + 1]); w.y = cvt_pk_bf16(acc3[4 * g + 2], acc3[4 * g + 3]); *(u32x2*)(yb + 96 + 8 * g) = w;
        }
    }
    }
}

__device__ __forceinline__ void conv8(const bf16_t* src, int pitch, bool hasp, bool hasn, const float* w, int C, const float* b, float (&o)[8]) {
    const u32x4 z = zero4();
    const u32x4 cu = *(const u32x4*)src; const u32x4 pv = hasp ? *(const u32x4*)(src - pitch) : z; const u32x4 nx = hasn ? *(const u32x4*)(src + pitch) : z;
    const f32x4 w0a = *(const f32x4*)(w), w0b = *(const f32x4*)(w + 4), w1a = *(const f32x4*)(w + C), w1b = *(const f32x4*)(w + C + 4), w2a = *(const f32x4*)(w + 2 * C), w2b = *(const f32x4*)(w + 2 * C + 4);
    const f32x4 ba = *(const f32x4*)b, bb = *(const f32x4*)(b + 4);
    o[0] = w0a[0] * bflo(pv.x) + w1a[0] * bflo(cu.x) + w2a[0] * bflo(nx.x) + ba[0];
    o[1] = w0a[1] * bfhi(pv.x) + w1a[1] * bfhi(cu.x) + w2a[1] * bfhi(nx.x) + ba[1];
    o[2] = w0a[2] * bflo(pv.y) + w1a[2] * bflo(cu.y) + w2a[2] * bflo(nx.y) + ba[2];
    o[3] = w0a[3] * bfhi(pv.y) + w1a[3] * bfhi(cu.y) + w2a[3] * bfhi(nx.y) + ba[3];
    o[4] = w0b[0] * bflo(pv.z) + w1b[0] * bflo(cu.z) + w2b[0] * bflo(nx.z) + bb[0];
    o[5] = w0b[1] * bfhi(pv.z) + w1b[1] * bfhi(cu.z) + w2b[1] * bfhi(nx.z) + bb[1];
    o[6] = w0b[2] * bflo(pv.w) + w1b[2] * bflo(cu.w) + w2b[2] * bflo(nx.w) + bb[2];
    o[7] = w0b[3] * bfhi(pv.w) + w1b[3] * bfhi(cu.w) + w2b[3] * bfhi(nx.w) + bb[3];
}


#define XB_TMO      128
#define XB_XCNT(j)  (256  + 64 * (j))
#define XB_XSUB(j)  (1280 + 64 * (j))
#define XB_XGEN(j)  (2304 + 64 * (j))
#define XB_TOP      3328
#define XB_TOPGEN   3392
#define XCD_BAR_WORDS 3456
#define XB_SPIN_CAP (1u << 18)
__device__ __forceinline__ unsigned xb_ld(unsigned* p)              { return __hip_atomic_load(p, __ATOMIC_RELAXED, __HIP_MEMORY_SCOPE_AGENT); }
__device__ __forceinline__ unsigned xb_add(unsigned* p, unsigned v) { return __hip_atomic_fetch_add(p, v, __ATOMIC_RELAXED, __HIP_MEMORY_SCOPE_AGENT); }
__device__ __forceinline__ unsigned xb_xcc_id() { return (unsigned)__builtin_amdgcn_s_getreg((3 << 11) | 20) & 0xFu; }
#define XB_SPIN(cond, bar) do { unsigned _sp = 0; while (cond) { __builtin_amdgcn_s_sleep(1); \
    if ((++_sp & 255u) == 0u) { if (xb_ld(&(bar)[XB_TMO])) break; if (_sp > XB_SPIN_CAP) { atomicAdd(&(bar)[XB_TMO], 1u); break; } } } } while (0)
__device__ __forceinline__ void xcd_barrier_complete(unsigned* bar, unsigned x, unsigned& nloc, unsigned& nx) {
    const unsigned G = gridDim.x * gridDim.y * gridDim.z;
    unsigned sum, cnt, mine, sp = 0u;
    for (;;) {
        sum = 0u; cnt = 0u; mine = 0u;
#pragma unroll
        for (unsigned j = 0; j < 16; ++j) { const unsigned c = xb_ld(&bar[XB_XCNT(j)]); sum += c; cnt += (c > 0u) ? 1u : 0u; mine = (j == x) ? c : mine; }
        if (sum == G) break;
        __builtin_amdgcn_s_sleep(1);
        if ((++sp & 255u) == 0u) { if (xb_ld(&bar[XB_TMO])) break; if (sp > XB_SPIN_CAP) { atomicAdd(&bar[XB_TMO], 1u); break; } }
    }
    nloc = mine > 0u ? mine : 1u; nx = cnt > 0u ? cnt : 1u;
}
__device__ __forceinline__ void xcd_barrier(unsigned* bar, volatile LAS unsigned* st) {
    asm volatile("s_waitcnt vmcnt(0)" ::: "memory");
    __syncthreads();
    if (threadIdx.x == 0) {
        const unsigned x = xb_xcc_id();
        __builtin_amdgcn_s_waitcnt(0);
        unsigned nloc = st[0], nx = st[1];
        if (nloc == 0u) { xcd_barrier_complete(bar, x, nloc, nx); st[0] = nloc; st[1] = nx; }
        const unsigned old = xb_add(&bar[XB_XSUB(x)], 1u);
        const unsigned gen = old / nloc;
        if (old + 1u == (gen + 1u) * nloc) {
            __builtin_amdgcn_fence(__ATOMIC_RELEASE, "agent");
            asm volatile("s_waitcnt vmcnt(0)" ::: "memory");
            const unsigned og = xb_add(&bar[XB_TOP], 1u);
            const unsigned tg = og / nx;
            if (og + 1u == (tg + 1u) * nx) xb_add(&bar[XB_TOPGEN], 1u);
            else XB_SPIN(xb_ld(&bar[XB_TOPGEN]) == tg, bar);
            __builtin_amdgcn_fence(__ATOMIC_ACQUIRE, "agent");
            xb_add(&bar[XB_XGEN(x)], 1u);
            asm volatile("s_waitcnt vmcnt(0)" ::: "memory");
        } else {
            XB_SPIN(xb_ld(&bar[XB_XGEN(x)]) == gen, bar);
            __builtin_amdgcn_fence(__ATOMIC_ACQUIRE, "agent");
            asm volatile("s_waitcnt vmcnt(0)" ::: "memory");
        }
    }
    __syncthreads();
}

#ifndef PHMASK
#define PHMASK 0xFFFFu
#endif
#ifndef REPMASK
#define REPMASK 0u
#endif
#define MISC_OFF 147392
#define GSYNC() do { kparams_t KPb = kparams(); xcd_barrier((unsigned*)(KPb->ws + WS_CTL), (volatile LAS unsigned*)(lds + MISC_OFF)); } while (0)
#define REPS(k) for (int rep_ = 0; rep_ < 1 + (int)((REPMASK >> (k)) & 1u); ++rep_)
constexpr int LDS_BYTES = 147456;
typedef const __attribute__((address_space(4))) Params* kparams_t;
__device__ __forceinline__ kparams_t kparams() { kparams_t p = (kparams_t)__builtin_amdgcn_kernarg_segment_ptr(); asm volatile("" : "+s"(p)); return p; }
#define PIN(i) ((const float*)KP->in[i])
__device__ __forceinline__ const float* xin_ptr(kparams_t KP, int chunk) { int c = chunk; asm volatile("" : "+s"(c)); return c == 0 ? (const float*)KP->in[0] : (const float*)KP->in[1] + ((size_t)(c - 1) << 25); }
__device__ __forceinline__ float* outc_ptr(kparams_t KP, int chunk) { int c = chunk; asm volatile("" : "+s"(c)); return (float*)KP->out + ((size_t)c << 25); }
#define WSB(off) ((bf16_t*)(ws + (off)))
#define WSF(off) ((float*)(ws + (off)))
#define PHASE_BEGIN kparams_t KP = kparams(); unsigned char* ws = KP->ws; (void)ws; int tid = threadIdx.x; asm volatile("" : "+v"(tid)); const int lane = tid & 63; const int wid = __builtin_amdgcn_readfirstlane(tid >> 6); const int gw = bid * 8 + wid; (void)lane; (void)gw;
#define PART1 WSF(WS_PART1)
#define PART2 WSF(WS_PART2)
#define RSTD1 WSF(WS_RSTD1)
#define ROPE ((f32x2*)(ws + WS_ROPE))
#define H3 WSF(WS_H3)
#define WIN WSB(WS_WIN)
#define WUP WSB(WS_WUP)
#define WDN WSB(WS_WDN)
#define WOUT WSB(WS_WOUT)
#define WA WSB(WS_WA)
#define WH WSB(WS_WH)
#define F4 WSB(WS_F4)
#define F8 WSB(WS_F8)
#define XB WSB(WS_XB)
#define MG WSB(WS_R23)
#define X1B WSB(WS_R1 + R1_UT)
#define X2B WSB(WS_R1 + R1_UT)
#define ACT WSB(WS_R23)
#define QB WSB(WS_R1 + R1_QB)
#define KB WSB(WS_R1 + R1_KB)
#define VB WSB(WS_R1 + R1_VB)
#define HY WSB(WS_R1 + R1_HY)
#define GT WSB(WS_R1 + R1_GT)
#define AT WSB(WS_R1 + R1_AT)
#define HN WSB(WS_R1 + R1_HN)
#define UT WSB(WS_R1 + R1_UT)
#define YT WSB(WS_R1 + R1_YT)
#define XT WSB(WS_R1 + R1_XT)
#define T1 WSB(WS_R1 + R1_QB)
#define UP WSB(WS_R1 + R1_QB)
#define BODY_PA(CK) do { const float* xin_ = xin_ptr(KP, (CK)); \
        for (int row = gw; row < CH; row += NGW) { \
            const f32x4* xr = (const f32x4*)(xin_ + (size_t)row * DM) + lane; \
            f32x4 v[8]; float s = 0.f; \
            _Pragma("unroll") for (int j = 0; j < 8; ++j) { v[j] = xr[64 * j]; s += (v[j][0] * v[j][0] + v[j][1] * v[j][1]) + (v[j][2] * v[j][2] + v[j][3] * v[j][3]); } \
            s = wave_sum(s, lane); \
            if (lane == 0) RSTD1[row] = rsqrtf(s * (1.0f / DM) + EPS); \
            u32x2* o = (u32x2*)(XB + (size_t)row * DM) + lane; \
            _Pragma("unroll") for (int j = 0; j < 8; ++j) { u32x2 w; w.x = cvt_pk_bf16(v[j][0], v[j][1]); w.y = cvt_pk_bf16(v[j][2], v[j][3]); o[64 * j] = w; } \
        } } while (0)
#define BODY_FINAL(CK) do { const float* nf = PIN(29); float* outc_ = outc_ptr(KP, (CK)); \
        for (int row = gw; row < CH; row += NGW) { \
            float s = (lane < 32) ? PART2[(size_t)row * 32 + lane] : 0.f; \
            s = wave_sum(s, lane); \
            const float rs = rsqrtf(s * (1.0f / DM) + EPS); \
            const u32x4* xr = (const u32x4*)(X2B + (size_t)row * DM) + lane; f32x4* orow = (f32x4*)(outc_ + (size_t)row * DM); const f32x4* gr = (const f32x4*)nf; \
            _Pragma("unroll") for (int j = 0; j < 4; ++j) { \
                const u32x4 w = xr[64 * j]; const int e4 = 2 * (lane + 64 * j); \
                const f32x4 g0 = gr[e4], g1 = gr[e4 + 1]; \
                orow[e4] = (f32x4){bflo(w.x) * rs * g0[0], bfhi(w.x) * rs * g0[1], bflo(w.y) * rs * g0[2], bfhi(w.y) * rs * g0[3]}; \
                orow[e4 + 1] = (f32x4){bflo(w.z) * rs * g1[0], bfhi(w.z) * rs * g1[1], bflo(w.w) * rs * g1[2], bfhi(w.w) * rs * g1[3]}; \
            } } } while (0)
__global__ void __launch_bounds__(512, 2) mega_fwd(Params P) {
    extern __shared__ __attribute__((aligned(16))) unsigned char lds_raw[];
    LAS unsigned char* lds = (LAS unsigned char*)lds_raw;
    cg::grid_group grid = cg::this_grid();
    const int G = gridDim.x, bid = blockIdx.x;
    const int NGW = G * 8;
    if (threadIdx.x < 2) ((volatile LAS unsigned*)(lds + MISC_OFF))[threadIdx.x] = 0u;
    { kparams_t KPb = kparams(); if (threadIdx.x == 0) (void)xb_add(&((unsigned*)(KPb->ws + WS_CTL))[XB_XCNT(xb_xcc_id())], 1u); }
    __syncthreads();
    if (PHMASK & (1u << 0)) { PHASE_BEGIN
        LAS float* scr = (LAS float*)(lds + wid * 16640);
        constexpr int I_IN = 32 * 160, I_UP = 32 * 176, I_DN = 88 * 32, I_OUT = 32 * 32, I_A = 16 * 32;
        constexpr int NIT = I_IN + I_UP + I_DN + I_OUT + 2 * I_A;
        REPS(0) for (int it = gw; it < NIT; it += NGW) {
            int r = it;
            if (r < I_IN) { transpose_item(PIN(3), DM, INW, WIN, PIN(2), true, scr, r, lane); continue; } r -= I_IN;
            if (r < I_UP) { transpose_item(PIN(25), DM, UPW, WUP, PIN(24), false, scr, r, lane); continue; } r -= I_UP;
            if (r < I_DN) { transpose_item(PIN(28), DFF, DM, WDN, nullptr, false, scr, r, lane); continue; } r -= I_DN;
            if (r < I_OUT) { transpose_item(PIN(23), DM, DM, WOUT, nullptr, false, scr, r, lane); continue; } r -= I_OUT;
            if (r < I_A) { transpose_item(PIN(21), 1024, DM, WA, nullptr, false, scr, r, lane, 2048, 0); continue; } r -= I_A;
            transpose_item(PIN(22), 1024, DM, WA, nullptr, false, scr, r, lane, 2048, 1024);
        }
        REPS(0) for (int e = bid * 512 + tid; e < 8192 * 32; e += G * 512) {
            const int pos = e >> 5, i = e & 31;
            const float inv = (float)exp2(-(double)(2 * i) / 64.0 * 13.287712379549449);
            const float ang = (float)pos * inv;
            double s, c; sincos_d((double)ang, s, c);
            ROPE[e] = (f32x2){(float)c, (float)s};
        }
        const float* w1 = PIN(12); const float* b1 = PIN(13); const float* w2 = PIN(14); const float* b2 = PIN(15); const float* w3 = PIN(16); const float* b3 = PIN(17); const float* fq_ = PIN(19);
        const float fr = fq_[lane];
        REPS(0) for (int it = gw; it < 4096 + 8192; it += NGW) {
            const int L = it < 4096 ? 4096 : 8192, t = it < 4096 ? it : it - 4096;
            const float tn = (float)t / (float)(L - 1);
            const float w = 6.283185307179586f * (float)t / (float)L;
            float z = 0.f;
            if (lane == 0) z = tn;
            else if (lane <= 32) {
                const int k = (lane - 1) & 15;
                const float f = 1e-4f + (float)k * ((15.0f - 1e-4f) / 15.0f);
                double s, c; sincos_d((double)(f * w), s, c);
                z = (lane <= 16) ? (float)c : (float)(-s);
            }
            float a = b1[lane];
#pragma unroll 11
            for (int e = 0; e < 33; ++e) a += __shfl(z, e) * w1[e * 64 + lane];
            float h = sin_f(fr * a);
            a = b2[lane];
#pragma unroll 16
            for (int e = 0; e < 64; ++e) a += __shfl(h, e) * w2[e * 64 + lane];
            h = sin_f(fr * a);
            a = b3[lane];
#pragma unroll 16
            for (int e = 0; e < 64; ++e) a += __shfl(h, e) * w3[e * 64 + lane];
            h = sin_f(fr * a);
            H3[(size_t)it * 64 + lane] = h;
        }
    }
    grid.sync();
    if (PHMASK & (1u << 1)) { PHASE_BEGIN
        const float* w4 = PIN(18); const float* hb = PIN(20);
        const int NI4 = 64 * 256, NI8 = 128 * 256;
        REPS(1) for (int it = gw; it < NI4 + NI8; it += NGW) {
            const bool is8 = it >= NI4; const int L = is8 ? 8192 : 4096; const int r = is8 ? it - NI4 : it;
            const int tb = r >> 8, cg8 = r & 255; const int t = tb * 64 + lane;
            const float* hrow = H3 + (size_t)((is8 ? 4096 : 0) + t) * 64;
            bf16_t* Fb = is8 ? F8 : F4;
            const float tn = (float)t / (float)(L - 1);
            float acc8[8];
#pragma unroll
            for (int cc = 0; cc < 8; ++cc) acc8[cc] = 0.f;
#pragma unroll 2
            for (int jb = 0; jb < 16; ++jb) {
                const f32x4 h4 = *(const f32x4*)(hrow + 4 * jb);
#pragma unroll
                for (int jj = 0; jj < 4; ++jj) {
                    const f32x4 wa = *(const f32x4*)(w4 + (4 * jb + jj) * 2048 + cg8 * 8), wb = *(const f32x4*)(w4 + (4 * jb + jj) * 2048 + cg8 * 8 + 4);
#pragma unroll
                    for (int e = 0; e < 4; ++e) { acc8[e] += h4[jj] * wa[e]; acc8[4 + e] += h4[jj] * wb[e]; }
                }
            }
#pragma unroll
            for (int cc = 0; cc < 8; ++cc) {
                const int cp = cg8 * 8 + cc;
                const float a = acc8[cc];
                const int c = cp & 1023; const bool bwd = cp >= 1024;
                const float mind = -3.0701134573253946f, maxd = -15.350567286626973f;
                const float delta = fabsf(mind + (float)c * ((maxd - mind) / 1023.0f));
                float val = a * __expf(-tn * delta);
                bf16_t* f0 = Fb + (size_t)c * 4 * L; bf16_t* f1 = f0 + 2 * L;
                if (!bwd) { if (t == 0) val += hb[c]; const int x = L - t; const bf16_t v = (bf16_t)f2bf(val); f0[x] = v; f1[x - 1] = v; }
                else if (t > 0) { const int x = L + t; const bf16_t v = (bf16_t)f2bf(val); f0[x] = v; f1[x - 1] = v; }
                else { f0[0] = 0; f1[2 * L - 1] = 0; }
            }
        }
    }

    if (PHMASK & (1u << 2)) { PHASE_BEGIN BODY_PA(0); }
#pragma unroll 1
    for (int chunk = 0; chunk < NCHUNK; ++chunk) {
        const int L = chunk == 0 ? 4096 : 8192;
#define xin xin_ptr(KP, chunk)
#define outc outc_ptr(KP, chunk)
#define FILT (chunk == 0 ? F4 : F8)
        GSYNC();
        if (PHMASK & (1u << 3)) { PHASE_BEGIN
#pragma unroll 1
            for (int step = 0; step < 2; ++step) {
                if ((step == 0) != ((bid & 1) != 0)) {
                    pg8::Gemm g{XB, WIN, CH, INW, DM}; pg8::StaticOrder S; S.init(CH, INW, G, bid);
                    Epi1 E{QB, KB, VB, HY, GT, XT, RSTD1, PIN(6), ROPE, L};
                    REPS(3) pg8::gemm_phase<Epi1, true>(lds, g, S, E);
                } else if (chunk > 0) { BODY_FINAL(chunk - 1); }
            }
        }
        GSYNC();
        if (PHMASK & (1u << 5)) { PHASE_BEGIN
            const int nqb = L / 256;
            float lam;
            { const float a = wave_sum(PIN(7)[lane] * PIN(8)[lane], lane), b = wave_sum(PIN(9)[lane] * PIN(10)[lane], lane); lam = __expf(a) - __expf(b) + LAMBDA_INIT; }
            const int vb = (G == 256) ? ((bid & 7) * 32 + (bid >> 3)) : bid;
            REPS(5) for (int it0 = vb; it0 < 512; it0 += G) {
                const int it = it0; const int nqsh = (L == 4096) ? 4 : 5; const int qb = it & (nqb - 1), sh = it >> nqsh, h = sh & 7, s = sh >> 3;
                attn_item(lds, QB, KB, VB, AT, s * L, h, qb, L, lam, PIN(11));
            }
            REPS(13) for (int c = bid; c < 1024; c += G) hyena_item(lds, FILT, XT, PIN(4), PIN(5), YT, c, L);
            __syncthreads();
        }
        GSYNC();
        if (PHMASK & (1u << 6)) { PHASE_BEGIN
            const float* cw = PIN(4); const float* cb = PIN(5);
            LAS bf16_t* tl = (LAS bf16_t*)lds;
            for (int tix = bid; tix < 4096; tix += G) {
                const int tb = tix >> 4, cbk = tix & 15;
                { const int ch = tid >> 3, seg = tid & 7; *(LAS u32x4*)(tl + ch * 72 + seg * 8) = *(const u32x4*)(YT + (size_t)(cbk * 64 + ch) * CH + tb * 64 + seg * 8); }
                __syncthreads();
                const int tr = tid >> 3, tc = tid & 7; const int tok = tb * 64 + tr, pos = tok & (L - 1), c0 = cbk * 64 + tc * 8;
                float a[8];
                conv8(HY + (size_t)tok * 3072 + c0, 3072, pos > 0, pos < L - 1, cw + c0, 3072, cb + c0, a);
                u32x4 w;
                w.x = cvt_pk_bf16(a[0] * bf2f(tl[(tc * 8 + 0) * 72 + tr]), a[1] * bf2f(tl[(tc * 8 + 1) * 72 + tr]));
                w.y = cvt_pk_bf16(a[2] * bf2f(tl[(tc * 8 + 2) * 72 + tr]), a[3] * bf2f(tl[(tc * 8 + 3) * 72 + tr]));
                w.z = cvt_pk_bf16(a[4] * bf2f(tl[(tc * 8 + 4) * 72 + tr]), a[5] * bf2f(tl[(tc * 8 + 5) * 72 + tr]));
                w.w = cvt_pk_bf16(a[6] * bf2f(tl[(tc * 8 + 6) * 72 + tr]), a[7] * bf2f(tl[(tc * 8 + 7) * 72 + tr]));
                *(u32x4*)(AT + (size_t)tok * 2048 + 1024 + c0) = w;
                __syncthreads();
            }
        }
        GSYNC();
        if (PHMASK & (1u << 7)) { PHASE_BEGIN
            pg8::Gemm g{AT, WA, CH, DM, DM}; pg8::StaticOrder S; S.init(CH, DM, G, bid);
            Epi2M E{GT, MG};
            pg8::gemm_phase<Epi2M, true>(lds, g, S, E);
        }
        GSYNC();
        if (PHMASK & (1u << 8)) { PHASE_BEGIN
            pg8::Gemm g{MG, WOUT, CH, DM, DM}; pg8::StaticOrder S; S.init(CH, DM, G, bid);
            EpiResB E{XB, X1B, PART1};
            pg8::gemm_phase<EpiResB, true>(lds, g, S, E);
        }
        GSYNC();
        if (PHMASK & (1u << 9)) { PHASE_BEGIN
#pragma unroll 1
            for (int step = 0; step < 2; ++step) {
                if ((step == 0) != ((bid & 1) != 0)) {
                    pg8::Gemm g{X1B, WUP, CH, UPW, DM}; pg8::StaticOrder S; S.init(CH, UPW, G, bid);
                    Epi4 E{UP, PART1};
                    REPS(9) pg8::gemm_phase<Epi4, true>(lds, g, S, E);
                } else if (chunk + 1 < NCHUNK) { BODY_PA(chunk + 1); }
            }
        }
        GSYNC();
        if (PHMASK & (1u << 10)) { PHASE_BEGIN
            const float* cw = PIN(26); const float* cb = PIN(27);
            const int nitems = (CH / 16) * 704;
            REPS(10) for (int it = bid * 512 + tid; it < nitems; it += G * 512) {
                const int cgp = it % 704, rb = it / 704; const int c0 = cgp * 8, r0 = rb * 16; const int pos0 = r0 & (L - 1);
                float wg[3][8], wv[3][8], bg[8], bv[8];
#pragma unroll
                for (int j = 0; j < 3; ++j) {
                    const f32x4 a0 = *(const f32x4*)(cw + j * UPW + c0), a1 = *(const f32x4*)(cw + j * UPW + c0 + 4), b0 = *(const f32x4*)(cw + j * UPW + DFF + c0), b1 = *(const f32x4*)(cw + j * UPW + DFF + c0 + 4);
#pragma unroll
                    for (int e = 0; e < 4; ++e) { wg[j][e] = a0[e]; wg[j][4 + e] = a1[e]; wv[j][e] = b0[e]; wv[j][4 + e] = b1[e]; }
                }
                { const f32x4 a0 = *(const f32x4*)(cb + c0), a1 = *(const f32x4*)(cb + c0 + 4), b0 = *(const f32x4*)(cb + DFF + c0), b1 = *(const f32x4*)(cb + DFF + c0 + 4);
#pragma unroll
                  for (int e = 0; e < 4; ++e) { bg[e] = a0[e]; bg[4 + e] = a1[e]; bv[e] = b0[e]; bv[4 + e] = b1[e]; } }
                const bf16_t* up = UP + (size_t)r0 * UPW + c0;
                const u32x4 z4 = zero4();
                u32x4 pg = (pos0 > 0) ? *(const u32x4*)(up - UPW) : z4, pv = (pos0 > 0) ? *(const u32x4*)(up - UPW + DFF) : z4;
                u32x4 cg_ = *(const u32x4*)up, cv = *(const u32x4*)(up + DFF);
#pragma unroll 4
                for (int rr = 0; rr < 16; ++rr) {
                    const bool hn = (pos0 + rr) < L - 1;
                    const u32x4 ng = hn ? *(const u32x4*)(up + (size_t)(rr + 1) * UPW) : z4, nv = hn ? *(const u32x4*)(up + (size_t)(rr + 1) * UPW + DFF) : z4;
                    float o[8];
#define ACT1(e, PW, CW, NW, PV_, CV_, NV_, SEL) { const float g = wg[0][e] * SEL(PW) + wg[1][e] * SEL(CW) + wg[2][e] * SEL(NW) + bg[e]; const float v = wv[0][e] * SEL(PV_) + wv[1][e] * SEL(CV_) + wv[2][e] * SEL(NV_) + bv[e]; o[e] = g / (1.0f + __expf(-g)) * v; }
                    ACT1(0, pg.x, cg_.x, ng.x, pv.x, cv.x, nv.x, bflo) ACT1(1, pg.x, cg_.x, ng.x, pv.x, cv.x, nv.x, bfhi)
                    ACT1(2, pg.y, cg_.y, ng.y, pv.y, cv.y, nv.y, bflo) ACT1(3, pg.y, cg_.y, ng.y, pv.y, cv.y, nv.y, bfhi)
                    ACT1(4, pg.z, cg_.z, ng.z, pv.z, cv.z, nv.z, bflo) ACT1(5, pg.z, cg_.z, ng.z, pv.z, cv.z, nv.z, bfhi)
                    ACT1(6, pg.w, cg_.w, ng.w, pv.w, cv.w, nv.w, bflo) ACT1(7, pg.w, cg_.w, ng.w, pv.w, cv.w, nv.w, bfhi)
#undef ACT1
                    u32x4 w; w.x = cvt_pk_bf16(o[0], o[1]); w.y = cvt_pk_bf16(o[2], o[3]); w.z = cvt_pk_bf16(o[4], o[5]); w.w = cvt_pk_bf16(o[6], o[7]);
                    *(u32x4*)(ACT + (size_t)(r0 + rr) * DFF + c0) = w;
                    pg = cg_; pv = cv; cg_ = ng; cv = nv;
                }
            }
        }
        GSYNC();
        if (PHMASK & (1u << 11)) { PHASE_BEGIN
            pg8::Gemm g{ACT, WDN, CH, DM, DFF}; pg8::StaticOrder S; S.init(CH, DM, G, bid);
            EpiResB E{X1B, X2B, PART2};
            pg8::gemm_phase<EpiResB, true>(lds, g, S, E);
        }
    }
    GSYNC();
    if (PHMASK & (1u << 12)) { PHASE_BEGIN BODY_FINAL(NCHUNK - 1); }
}

extern "C" void kernel_launch(void* const* d_in, const int* in_sizes, int n_in, void* d_out, int out_size, void* d_ws, size_t ws_size, hipStream_t stream) {
    static int grid = 0;
    if (grid == 0) {
        if (n_in != 30 || ws_size < WS_END) { fprintf(stderr, "kernel_launch: unexpected n_in %d or ws_size %zu\n", n_in, ws_size); grid = -1; return; }
        int dev = 0, cus = 0, per_cu = 0;
        (void)hipGetDevice(&dev);
        (void)hipDeviceGetAttribute(&cus, hipDeviceAttributeMultiprocessorCount, dev);
        (void)hipFuncSetAttribute((const void*)mega_fwd, hipFuncAttributeMaxDynamicSharedMemorySize, LDS_BYTES);
        (void)hipOccupancyMaxActiveBlocksPerMultiprocessor(&per_cu, (const void*)mega_fwd, 512, LDS_BYTES);
        (void)hipGetLastError();
        if (per_cu < 1) per_cu = 1;
        grid = cus;
        fprintf(stderr, "kernel_launch: cus %d per_cu %d grid %d\n", cus, per_cu, grid);
    }
    if (grid < 0) return;
    if (hipMemsetAsync((char*)d_ws + WS_CTL, 0, CTL_BYTES, stream) != hipSuccess) { fprintf(stderr, "kernel_launch: memset failed\n"); return; }
    Params p{};
    for (int i = 0; i < 30; ++i) p.in[i] = (const float*)d_in[i];
    p.out = (float*)d_out; p.ws = (unsigned char*)d_ws;
    void* args[] = {&p};
    hipError_t e = hipLaunchCooperativeKernel((const void*)mega_fwd, dim3(grid), dim3(512), args, LDS_BYTES, stream);
    if (e != hipSuccess) fprintf(stderr, "cooperative launch failed: %s (grid %d)\n", hipGetErrorString(e), grid);
}
```

```cpp
#include <hip/hip_runtime.h>
#include <hip/hip_cooperative_groups.h>
#include <cstdio>
#include <cstdint>
namespace cg = cooperative_groups;

#define LAS __attribute__((address_space(3)))
typedef unsigned short bf16_t;
typedef short bf16x8 __attribute__((ext_vector_type(8)));
typedef short s16x4 __attribute__((ext_vector_type(4)));
typedef float f32x2 __attribute__((ext_vector_type(2)));
typedef float f32x4 __attribute__((ext_vector_type(4)));
typedef float f32x16 __attribute__((ext_vector_type(16)));
typedef unsigned u32x2 __attribute__((ext_vector_type(2)));
typedef unsigned u32x4 __attribute__((ext_vector_type(4)));

constexpr int DM = 2048, CH = 16384, NCHUNK = 3;
constexpr int INW = 10240, DFF = 5632, UPW = 11264;
constexpr float EPS = 1e-6f;
constexpr float QSCALE = 0.125f * 1.4426950408889634f;
constexpr float LAMBDA_INIT = 0.2f;

constexpr size_t MiB = 1u << 20;
constexpr size_t WS_PART1 = 0, WS_PART2 = 2 * MiB, WS_RSTD1 = 4 * MiB, WS_ROPE = 5 * MiB, WS_H3 = 7 * MiB;
constexpr size_t WS_WIN = 10 * MiB, WS_WUP = 50 * MiB, WS_WDN = 94 * MiB, WS_WOUT = 116 * MiB, WS_WA = 124 * MiB, WS_WH = 128 * MiB;
constexpr size_t WS_F4 = 132 * MiB, WS_F8 = 164 * MiB;
constexpr size_t WS_R23 = 228 * MiB;
constexpr size_t WS_R1 = 404 * MiB;
constexpr size_t WS_XB = 916 * MiB;
constexpr size_t WS_CTL = 980 * MiB, CTL_BYTES = 16384;
constexpr size_t WS_END = 981 * MiB;
constexpr size_t R1_QB = 0, R1_KB = 32 * MiB, R1_VB = 64 * MiB, R1_HY = 96 * MiB, R1_GT = 192 * MiB, R1_AT = 320 * MiB, R1_HN = 352 * MiB, R1_UT = 384 * MiB, R1_YT = 416 * MiB, R1_XT = 448 * MiB;

struct Params { const float* in[30]; float* out; unsigned char* ws; };

__device__ __forceinline__ float bflo(unsigned w) { return __uint_as_float(w << 16); }
__device__ __forceinline__ float bfhi(unsigned w) { return __uint_as_float(w & 0xffff0000u); }
__device__ __forceinline__ float bf2f(unsigned short h) { return __uint_as_float((unsigned)h << 16); }
__device__ __forceinline__ unsigned f2bf(float f) { unsigned u = __float_as_uint(f); return (u + 0x7fffu + ((u >> 16) & 1u)) >> 16; }
__device__ __forceinline__ unsigned pk2(float lo, float hi) { return f2bf(lo) | (f2bf(hi) << 16); }
typedef __bf16 bf16x2_t __attribute__((ext_vector_type(2)));
__device__ __forceinline__ unsigned cvt_pk_bf16(float lo, float hi) { f32x2 v = {lo, hi}; bf16x2_t b = __builtin_convertvector(v, bf16x2_t); return __builtin_bit_cast(unsigned, b); }
__device__ __forceinline__ float lane_xor_get(float v, int lane, int o) { return __int_as_float(__builtin_amdgcn_ds_bpermute((lane ^ o) << 2, __float_as_int(v))); }
__device__ __forceinline__ float wave_sum(float v, int lane) {
#pragma unroll
    for (int o = 1; o < 64; o <<= 1) v += lane_xor_get(v, lane, o);
    return v;
}
__device__ __forceinline__ float swap_add(float v) { auto rr = __builtin_amdgcn_permlane32_swap(__float_as_uint(v), __float_as_uint(v), false, false); return __uint_as_float(rr[0]) + __uint_as_float(rr[1]); }
__device__ __forceinline__ float swap_max(float v) { auto rr = __builtin_amdgcn_permlane32_swap(__float_as_uint(v), __float_as_uint(v), false, false); return fmaxf(__uint_as_float(rr[0]), __uint_as_float(rr[1])); }
__device__ __forceinline__ u32x4 zero4() { unsigned z = 0u; asm volatile("" : "+v"(z)); return (u32x4){z, z, z, z}; }
__device__ __forceinline__ void sincos_d(double x, double& s, double& c) {
    const double k = rint(x * 0.63661977236758134308);
    double r = fma(-k, 1.57079632679489655800e+00, x);
    r = fma(-k, 6.12323399573676603587e-17, r);
    const double r2 = r * r;
    const double sp = r * (1.0 + r2 * (-1.0 / 6.0 + r2 * (1.0 / 120.0 + r2 * (-1.0 / 5040.0 + r2 * (1.0 / 362880.0 + r2 * (-1.0 / 39916800.0 + r2 * (1.0 / 6227020800.0)))))));
    const double cp = 1.0 + r2 * (-0.5 + r2 * (1.0 / 24.0 + r2 * (-1.0 / 720.0 + r2 * (1.0 / 40320.0 + r2 * (-1.0 / 3628800.0 + r2 * (1.0 / 479001600.0 + r2 * (-1.0 / 87178291200.0)))))));
    const int q = ((int)k) & 3;
    const double ss = (q & 1) ? cp : sp, cc = (q & 1) ? sp : cp;
    s = (q & 2) ? -ss : ss;
    c = ((q + 1) & 2) ? -cc : cc;
}
__device__ __forceinline__ float sin_f(float x) { double s, c; sincos_d((double)x, s, c); return (float)s; }

namespace pg8 {
constexpr int BM = 256, BK = 64, HALF = 128, HTB = HALF * BK * 2, STAGE_BYTES = 8 * HTB, NXCD = 8, WGM = 8;
__host__ __device__ __forceinline__ int lds_byte(int r, int c) { const int st = (r >> 4) * 2 + (c >> 5), rr = r & 15, cc = c & 31, ob = rr * 64 + cc * 2; return st * 1024 + (ob ^ (((ob >> 9) & 1) << 5)); }
__host__ __device__ __forceinline__ void stage_rc(int b, int& R, int& C) { const int st = b / 1024, sb = b % 1024, swz = sb ^ (((sb >> 9) & 1) << 5); R = (st >> 1) * 16 + swz / 64; C = (st & 1) * 32 + (swz % 64) / 2; }
__host__ __device__ __forceinline__ int perm32(int rho) { const int n = rho >> 4, i = rho & 15; return 8 * (i >> 2) + 4 * n + (i & 3); }
struct Unit { int pm, pn; };
struct Gemm { const bf16_t* A; const bf16_t* Bt; int M, N, K; };
struct StaticOrder {
    int nM, nN, nwg, G, c;
    __device__ void init(int M, int N, int G_, int c_) { nM = M / BM; nN = N / BM; nwg = nM * nN; G = G_; c = c_; }
    __device__ bool next(int i, Unit& u) const {
        const long L = (long)i * G + c; if (L >= nwg) return false;
        int wgid = (int)L; { const int q = nwg / NXCD, r = nwg % NXCD, xcd = wgid % NXCD, off = wgid / NXCD; wgid = (xcd < r ? xcd * (q + 1) : r * (q + 1) + (xcd - r) * q) + off; }
        const int nig = WGM * nN, gid = wgid / nig, fm = gid * WGM, gsz = (nM - fm) < WGM ? (nM - fm) : WGM;
        u.pm = fm + ((wgid % nig) % gsz); u.pn = (wgid % nig) / gsz; return true;
    }
};
template <class Epi, bool ALIGN_EPI>
__device__ __forceinline__ void gemm_phase(LAS unsigned char* lds, const Gemm g, const StaticOrder& S, const Epi& E) {
    int tid = threadIdx.x; asm volatile("" : "+v"(tid));
    const int wid = __builtin_amdgcn_readfirstlane(tid >> 6), lane = tid & 63, wr = wid >> 2, wc = wid & 3, fr = lane & 15, fq = lane >> 4;
    const int K = g.K, nt = K / BK;
    unsigned voffA[2], voffB[2];
#pragma unroll
    for (int i = 0; i < 2; ++i) { int R, C; stage_rc(tid * 16 + i * 8192, R, C); const int Rb = Epi::PERM ? ((R & ~31) + perm32(R & 31)) : R;
        voffA[i] = (unsigned)(R * K + C) * 2u; voffB[i] = (unsigned)(Rb * K + C) * 2u; }
    const size_t kstep = (size_t)(BK * 2);
    const size_t hstep = (size_t)HALF * K * 2;
    const size_t tstep = 2 * hstep;
    const unsigned ldsw = (unsigned)wid * 1024u;
    const int aoff = lds_byte(wr * 64 + fr, fq * 8), boff = lds_byte(wc * 32 + fr, fq * 8);
#define PG8_SA(b, h) (((b) * 2 + (h)) * HTB)
#define PG8_SB(b, h) ((4 + (b) * 2 + (h)) * HTB)
#define PG8_STAGE(bufoff, gbase, voff) do { _Pragma("unroll") for (int _i = 0; _i < 2; ++_i) \
        __builtin_amdgcn_global_load_lds((const unsigned*)((const char*)(gbase) + (voff)[_i]), (LAS unsigned*)(lds + (bufoff) + ldsw + _i * 8192), 16, 0, 0); } while (0)
#define PG8_LDA(dst, b, h) do { _Pragma("unroll") for (int m = 0; m < 4; ++m) _Pragma("unroll") for (int k = 0; k < 2; ++k) dst[m][k] = *(const LAS bf16x8*)(lds + PG8_SA(b, h) + aoff + m * 2048 + k * 1024); } while (0)
#define PG8_LDB(dst, b, h) do { _Pragma("unroll") for (int n = 0; n < 2; ++n) _Pragma("unroll") for (int k = 0; k < 2; ++k) dst[n][k] = *(const LAS bf16x8*)(lds + PG8_SB(b, h) + boff + n * 2048 + k * 1024); } while (0)
#define PG8_MMA(ai, bj, At, Bt) do { __builtin_amdgcn_s_setprio(1); _Pragma("unroll") for (int m = 0; m < 4; ++m) _Pragma("unroll") for (int n = 0; n < 2; ++n) _Pragma("unroll") for (int k = 0; k < 2; ++k) \
        acc[ai][bj][m][n] = __builtin_amdgcn_mfma_f32_16x16x32_bf16(Bt[n][k], At[m][k], acc[ai][bj][m][n], 0, 0, 0); __builtin_amdgcn_s_setprio(0); } while (0)
#define PG8_WAIT_V(n) asm volatile("s_waitcnt vmcnt(" #n ")" ::: "memory")
#define PG8_WAIT_L(n) asm volatile("s_waitcnt lgkmcnt(" #n ")" ::: "memory")
#define PG8_BAR __builtin_amdgcn_s_barrier()
#define PG8_SCHED __builtin_amdgcn_sched_barrier(0)
    Unit cur, nxt; int ui = 0;
    if (!S.next(0, cur)) return;
    f32x4 acc[2][2][4][2];
#pragma unroll
    for (int a = 0; a < 2; ++a)
#pragma unroll
        for (int b = 0; b < 2; ++b)
#pragma unroll
            for (int m = 0; m < 4; ++m)
#pragma unroll
                for (int n = 0; n < 2; ++n) acc[a][b][m][n] = (f32x4){0.f, 0.f, 0.f, 0.f};
    bf16x8 At[4][2], B0[2][2], B1[2][2];
    const char* cA = (const char*)g.A + (size_t)cur.pm * tstep; const char* cB = (const char*)g.Bt + (size_t)cur.pn * tstep;
    PG8_STAGE(PG8_SB(0, 0), cB, voffB); PG8_STAGE(PG8_SB(0, 1), cB + hstep, voffB); PG8_STAGE(PG8_SA(0, 0), cA, voffA); PG8_STAGE(PG8_SA(0, 1), cA + hstep, voffA);
    if (wr == 1) PG8_BAR;
    PG8_WAIT_V(2); PG8_BAR;
    PG8_STAGE(PG8_SB(1, 0), cB + kstep, voffB); PG8_STAGE(PG8_SA(1, 0), cA + kstep, voffA); PG8_STAGE(PG8_SB(1, 1), cB + hstep + kstep, voffB);
    PG8_WAIT_V(6); PG8_BAR;
    for (;;) {
        const bool has_next = S.next(ui + 1, nxt);
        const char* nA = has_next ? (const char*)g.A + (size_t)nxt.pm * tstep : cA; const char* nB = has_next ? (const char*)g.Bt + (size_t)nxt.pn * tstep : cB;
        for (int t = 0; t < nt; t += 2) {
            const bool last = (t == nt - 2);
            const char* a1 = cA + (size_t)(t + 1) * kstep;
            const char* a2 = last ? nA : cA + (size_t)(t + 2) * kstep; const char* b2 = last ? nB : cB + (size_t)(t + 2) * kstep;
            const char* a3 = a2 + kstep; const char* b3 = b2 + kstep;
            PG8_LDB(B0, 0, 0); PG8_LDB(B1, 0, 1); PG8_SCHED; PG8_LDA(At, 0, 0); PG8_STAGE(PG8_SA(1, 1), a1 + hstep, voffA);
            PG8_WAIT_V(8); PG8_WAIT_L(0); PG8_BAR; PG8_MMA(0, 0, At, B0); PG8_MMA(0, 1, At, B1); PG8_BAR; PG8_SCHED;
            PG8_LDA(At, 0, 1); PG8_STAGE(PG8_SB(0, 0), b2, voffB); PG8_STAGE(PG8_SB(0, 1), b2 + hstep, voffB); PG8_STAGE(PG8_SA(0, 0), a2, voffA);
            PG8_WAIT_V(8); PG8_WAIT_L(0); PG8_BAR; PG8_MMA(1, 0, At, B0); PG8_MMA(1, 1, At, B1); PG8_BAR; PG8_SCHED;
            PG8_LDB(B0, 1, 0); PG8_LDB(B1, 1, 1); PG8_SCHED; PG8_LDA(At, 1, 0); PG8_STAGE(PG8_SA(0, 1), a2 + hstep, voffA);
            PG8_WAIT_V(8); PG8_WAIT_L(0); PG8_BAR; PG8_MMA(0, 0, At, B0); PG8_MMA(0, 1, At, B1); PG8_BAR; PG8_SCHED;
            PG8_LDA(At, 1, 1); PG8_STAGE(PG8_SB(1, 0), b3, voffB); PG8_STAGE(PG8_SB(1, 1), b3 + hstep, voffB); PG8_STAGE(PG8_SA(1, 0), a3, voffA);
            PG8_WAIT_V(8); PG8_WAIT_L(0); PG8_BAR; PG8_MMA(1, 0, At, B0); PG8_MMA(1, 1, At, B1); PG8_BAR; PG8_SCHED;
            if constexpr (Epi::MIDK) { if (t + 2 == (nt >> 1)) E.mid(acc, cur, wr, wc, fr, fq); }
        }
        if constexpr (ALIGN_EPI) { if (wr == 0) PG8_BAR; }
        E(acc, cur, wr, wc, fr, fq);
        if (!has_next) break;
#pragma unroll
        for (int a = 0; a < 2; ++a)
#pragma unroll
            for (int b = 0; b < 2; ++b)
#pragma unroll
                for (int m = 0; m < 4; ++m)
#pragma unroll
                    for (int n = 0; n < 2; ++n) acc[a][b][m][n] = (f32x4){0.f, 0.f, 0.f, 0.f};
        cur = nxt; cA = nA; cB = nB; ++ui;
        if constexpr (ALIGN_EPI) { if (wr == 1) PG8_BAR; }
    }
    PG8_WAIT_V(0);
    if constexpr (!ALIGN_EPI) { if (wr == 0) PG8_BAR; }
    PG8_BAR;
#undef PG8_SA
#undef PG8_SB
#undef PG8_STAGE
#undef PG8_LDA
#undef PG8_LDB
#undef PG8_MMA
#undef PG8_WAIT_V
#undef PG8_WAIT_L
#undef PG8_BAR
#undef PG8_SCHED
}
}

struct Epi1 {
    static constexpr bool PERM = true, MIDK = false;
    bf16_t *QB, *KB, *VB, *HY, *GT, *XTp; const float* rstd; const float* gate_b; const f32x2* rope; int L;
    __device__ __forceinline__ void operator()(const f32x4 (&acc)[2][2][4][2], const pg8::Unit& u, int wr, int wc, int fr, int fq) const {
        const int pn = u.pn; const int row0 = u.pm * 256 + wr * 64 + fr;
#pragma unroll
        for (int ai = 0; ai < 2; ++ai)
#pragma unroll
            for (int m = 0; m < 4; ++m) {
                const int row = row0 + ai * 128 + m * 16; const float rs = rstd[row]; const int pos = row & (L - 1);
#pragma unroll
                for (int bj = 0; bj < 2; ++bj) {
                    const int lc = bj * 128 + wc * 32 + 8 * fq;
                    f32x4 v0 = acc[ai][bj][m][0] * rs, v1 = acc[ai][bj][m][1] * rs;
                    bf16_t* dst;
                    if (pn < 8) {
                        const int col = (pn & 3) * 256 + lc; const int i0 = (col & 63) >> 1;
                        const f32x2* rp = rope + (size_t)pos * 32 + i0;
                        const f32x2 c0 = rp[0], c1 = rp[1], c2 = rp[2], c3 = rp[3];
                        const float sc = (pn < 4) ? QSCALE : 1.0f;
                        f32x4 w0, w1;
                        w0[0] = (v0[0] * c0[0] - v0[1] * c0[1]) * sc; w0[1] = (v0[1] * c0[0] + v0[0] * c0[1]) * sc;
                        w0[2] = (v0[2] * c1[0] - v0[3] * c1[1]) * sc; w0[3] = (v0[3] * c1[0] + v0[2] * c1[1]) * sc;
                        w1[0] = (v1[0] * c2[0] - v1[1] * c2[1]) * sc; w1[1] = (v1[1] * c2[0] + v1[0] * c2[1]) * sc;
                        w1[2] = (v1[2] * c3[0] - v1[3] * c3[1]) * sc; w1[3] = (v1[3] * c3[0] + v1[2] * c3[1]) * sc;
                        v0 = w0; v1 = w1;
                        dst = ((pn < 4) ? QB : KB) + (size_t)row * 1024 + col;
                    } else if (pn < 12) {
                        dst = VB + (size_t)row * 1024 + (pn - 8) * 256 + lc;
                    } else if (pn < 16) {
                        dst = HY + (size_t)row * 3072 + (pn - 12) * 256 + lc;
                    } else if (pn < 24) {
                        bf16_t* xt = XTp + (size_t)((pn - 16) * 256 + lc) * CH + row;
#pragma unroll
                        for (int e = 0; e < 4; ++e) { xt[(size_t)e * CH] = (bf16_t)f2bf(v0[e]); xt[(size_t)(4 + e) * CH] = (bf16_t)f2bf(v1[e]); }
                        continue;
                    } else {
                        const int gc = (pn - 24) * 256 + lc;
                        const f32x4 b0 = *(const f32x4*)(gate_b + gc), b1 = *(const f32x4*)(gate_b + gc + 4);
#pragma unroll
                        for (int e = 0; e < 4; ++e) { v0[e] = __builtin_amdgcn_rcpf(1.0f + __expf(-(v0[e] + b0[e]))); v1[e] = __builtin_amdgcn_rcpf(1.0f + __expf(-(v1[e] + b1[e]))); }
                        dst = GT + (size_t)row * 4096 + gc;
                    }
                    u32x4 w; w.x = cvt_pk_bf16(v0[0], v0[1]); w.y = cvt_pk_bf16(v0[2], v0[3]); w.z = cvt_pk_bf16(v1[0], v1[1]); w.w = cvt_pk_bf16(v1[2], v1[3]);
                    *(u32x4*)dst = w;
                }
            }
    }
};
template <int PASS> struct Epi2 {
    static constexpr bool PERM = true, MIDK = false;
    const bf16_t* GT; bf16_t* T1; bf16_t* MG;
    __device__ __forceinline__ void operator()(const f32x4 (&acc)[2][2][4][2], const pg8::Unit& u, int wr, int wc, int fr, int fq) const {
        const int row0 = u.pm * 256 + wr * 64 + fr;
#pragma unroll
        for (int ai = 0; ai < 2; ++ai)
#pragma unroll
            for (int m = 0; m < 4; ++m) {
                const int row = row0 + ai * 128 + m * 16;
#pragma unroll
                for (int bj = 0; bj < 2; ++bj) {
                    const int col = u.pn * 256 + bj * 128 + wc * 32 + 8 * fq;
                    const u32x4 gw = *(const u32x4*)(GT + (size_t)row * 4096 + PASS * 2048 + col);
                    f32x4 v0 = acc[ai][bj][m][0], v1 = acc[ai][bj][m][1];
                    v0[0] *= bflo(gw.x); v0[1] *= bfhi(gw.x); v0[2] *= bflo(gw.y); v0[3] *= bfhi(gw.y);
                    v1[0] *= bflo(gw.z); v1[1] *= bfhi(gw.z); v1[2] *= bflo(gw.w); v1[3] *= bfhi(gw.w);
                    if (PASS == 1) {
                        const u32x4 tw = *(const u32x4*)(T1 + (size_t)row * 2048 + col);
                        v0[0] += bflo(tw.x); v0[1] += bfhi(tw.x); v0[2] += bflo(tw.y); v0[3] += bfhi(tw.y);
                        v1[0] += bflo(tw.z); v1[1] += bfhi(tw.z); v1[2] += bflo(tw.w); v1[3] += bfhi(tw.w);
                    }
                    u32x4 w; w.x = cvt_pk_bf16(v0[0], v0[1]); w.y = cvt_pk_bf16(v0[2], v0[3]); w.z = cvt_pk_bf16(v1[0], v1[1]); w.w = cvt_pk_bf16(v1[2], v1[3]);
                    *(u32x4*)((PASS == 0 ? T1 : MG) + (size_t)row * 2048 + col) = w;
                }
            }
    }
};
struct Epi2M {
    static constexpr bool PERM = true, MIDK = true;
    const bf16_t* GT; bf16_t* MG;
    __device__ __forceinline__ void mid(f32x4 (&acc)[2][2][4][2], const pg8::Unit& u, int wr, int wc, int fr, int fq) const {
        int row0 = u.pm * 256 + wr * 64 + fr; asm volatile("" : "+v"(row0));
#pragma unroll
        for (int ai = 0; ai < 2; ++ai)
#pragma unroll
            for (int m = 0; m < 4; ++m) {
                const int row = row0 + ai * 128 + m * 16;
#pragma unroll
                for (int bj = 0; bj < 2; ++bj) {
                    const int col = u.pn * 256 + bj * 128 + wc * 32 + 8 * fq;
                    const u32x4 a = *(const u32x4*)(GT + (size_t)row * 4096 + col), b = *(const u32x4*)(GT + (size_t)row * 4096 + 2048 + col);
                    acc[ai][bj][m][0][0] *= bflo(a.x) * __builtin_amdgcn_rcpf(bflo(b.x)); acc[ai][bj][m][0][1] *= bfhi(a.x) * __builtin_amdgcn_rcpf(bfhi(b.x));
                    acc[ai][bj][m][0][2] *= bflo(a.y) * __builtin_amdgcn_rcpf(bflo(b.y)); acc[ai][bj][m][0][3] *= bfhi(a.y) * __builtin_amdgcn_rcpf(bfhi(b.y));
                    acc[ai][bj][m][1][0] *= bflo(a.z) * __builtin_amdgcn_rcpf(bflo(b.z)); acc[ai][bj][m][1][1] *= bfhi(a.z) * __builtin_amdgcn_rcpf(bfhi(b.z));
                    acc[ai][bj][m][1][2] *= bflo(a.w) * __builtin_amdgcn_rcpf(bflo(b.w)); acc[ai][bj][m][1][3] *= bfhi(a.w) * __builtin_amdgcn_rcpf(bfhi(b.w));
                    __builtin_amdgcn_sched_barrier(0);
                }
            }
    }
    __device__ __forceinline__ void operator()(const f32x4 (&acc)[2][2][4][2], const pg8::Unit& u, int wr, int wc, int fr, int fq) const {
        const int row0 = u.pm * 256 + wr * 64 + fr;
#pragma unroll
        for (int ai = 0; ai < 2; ++ai)
#pragma unroll
            for (int m = 0; m < 4; ++m) {
                const int row = row0 + ai * 128 + m * 16;
#pragma unroll
                for (int bj = 0; bj < 2; ++bj) {
                    const int col = u.pn * 256 + bj * 128 + wc * 32 + 8 * fq;
                    const u32x4 gw = *(const u32x4*)(GT + (size_t)row * 4096 + 2048 + col);
                    f32x4 v0 = acc[ai][bj][m][0], v1 = acc[ai][bj][m][1];
                    v0[0] *= bflo(gw.x); v0[1] *= bfhi(gw.x); v0[2] *= bflo(gw.y); v0[3] *= bfhi(gw.y);
                    v1[0] *= bflo(gw.z); v1[1] *= bfhi(gw.z); v1[2] *= bflo(gw.w); v1[3] *= bfhi(gw.w);
                    u32x4 w; w.x = cvt_pk_bf16(v0[0], v0[1]); w.y = cvt_pk_bf16(v0[2], v0[3]); w.z = cvt_pk_bf16(v1[0], v1[1]); w.w = cvt_pk_bf16(v1[2], v1[3]);
                    *(u32x4*)(MG + (size_t)row * 2048 + col) = w;
                }
            }
    }
};
template <bool WB> struct EpiRes {
    static constexpr bool PERM = false, MIDK = false;
    const float* base; float* out; bf16_t* ob; float* part;
    __device__ __forceinline__ void operator()(const f32x4 (&acc)[2][2][4][2], const pg8::Unit& u, int wr, int wc, int fr, int fq) const {
        const int row0 = u.pm * 256 + wr * 64 + fr;
#pragma unroll
        for (int ai = 0; ai < 2; ++ai)
#pragma unroll
            for (int m = 0; m < 4; ++m) {
                const int row = row0 + ai * 128 + m * 16; float ss = 0.f;
#pragma unroll
                for (int bj = 0; bj < 2; ++bj)
#pragma unroll
                    for (int n = 0; n < 2; ++n) {
                        const size_t off = (size_t)row * 2048 + u.pn * 256 + bj * 128 + wc * 32 + n * 16 + 4 * fq;
                        const f32x4 v = *(const f32x4*)(base + off) + acc[ai][bj][m][n];
                        *(f32x4*)(out + off) = v;
                        if (WB) { u32x2 w; w.x = cvt_pk_bf16(v[0], v[1]); w.y = cvt_pk_bf16(v[2], v[3]); *(u32x2*)(ob + off) = w; }
                        ss += (v[0] * v[0] + v[1] * v[1]) + (v[2] * v[2] + v[3] * v[3]);
                    }
                { const int ln = fr + 16 * fq; ss += lane_xor_get(ss, ln, 16); ss += lane_xor_get(ss, ln, 32); }
                if (fq == 0) part[(size_t)row * 32 + u.pn * 4 + wc] = ss;
            }
    }
};
struct EpiResB {
    static constexpr bool PERM = true, MIDK = false;
    const bf16_t* base; bf16_t* ob; float* part;
    __device__ __forceinline__ void operator()(const f32x4 (&acc)[2][2][4][2], const pg8::Unit& u, int wr, int wc, int fr, int fq) const {
        const int row0 = u.pm * 256 + wr * 64 + fr;
#pragma unroll
        for (int ai = 0; ai < 2; ++ai)
#pragma unroll
            for (int m = 0; m < 4; ++m) {
                const int row = row0 + ai * 128 + m * 16; float ss = 0.f;
#pragma unroll
                for (int bj = 0; bj < 2; ++bj) {
                    const size_t off = (size_t)row * 2048 + u.pn * 256 + bj * 128 + wc * 32 + 8 * fq;
                    const u32x4 bw = *(const u32x4*)(base + off);
                    f32x4 v0 = acc[ai][bj][m][0], v1 = acc[ai][bj][m][1];
                    v0[0] += bflo(bw.x); v0[1] += bfhi(bw.x); v0[2] += bflo(bw.y); v0[3] += bfhi(bw.y);
                    v1[0] += bflo(bw.z); v1[1] += bfhi(bw.z); v1[2] += bflo(bw.w); v1[3] += bfhi(bw.w);
                    ss += ((v0[0] * v0[0] + v0[1] * v0[1]) + (v0[2] * v0[2] + v0[3] * v0[3])) + ((v1[0] * v1[0] + v1[1] * v1[1]) + (v1[2] * v1[2] + v1[3] * v1[3]));
                    u32x4 w; w.x = cvt_pk_bf16(v0[0], v0[1]); w.y = cvt_pk_bf16(v0[2], v0[3]); w.z = cvt_pk_bf16(v1[0], v1[1]); w.w = cvt_pk_bf16(v1[2], v1[3]);
                    *(u32x4*)(ob + off) = w;
                }
                { const int ln = fr + 16 * fq; ss += lane_xor_get(ss, ln, 16); ss += lane_xor_get(ss, ln, 32); }
                if (fq == 0) part[(size_t)row * 32 + u.pn * 4 + wc] = ss;
            }
    }
};
struct Epi4 {
    static constexpr bool PERM = true, MIDK = false;
    bf16_t* UP; const float* part;
    __device__ __forceinline__ void operator()(const f32x4 (&acc)[2][2][4][2], const pg8::Unit& u, int wr, int wc, int fr, int fq) const {
        const int row0 = u.pm * 256 + wr * 64 + fr;
#pragma unroll
        for (int ai = 0; ai < 2; ++ai)
#pragma unroll
            for (int m = 0; m < 4; ++m) {
                const int row = row0 + ai * 128 + m * 16;
                const f32x4 pa = *(const f32x4*)(part + (size_t)row * 32 + 8 * fq), pb = *(const f32x4*)(part + (size_t)row * 32 + 8 * fq + 4);
                float s = ((pa[0] + pa[1]) + (pa[2] + pa[3])) + ((pb[0] + pb[1]) + (pb[2] + pb[3]));
                { const int ln = fr + 16 * fq; s += lane_xor_get(s, ln, 16); s += lane_xor_get(s, ln, 32); }
                const float rs = rsqrtf(s * (1.0f / 2048.0f) + EPS);
#pragma unroll
                for (int bj = 0; bj < 2; ++bj) {
                    const int col = u.pn * 256 + bj * 128 + wc * 32 + 8 * fq;
                    const f32x4 v0 = acc[ai][bj][m][0] * rs, v1 = acc[ai][bj][m][1] * rs;
                    u32x4 w; w.x = cvt_pk_bf16(v0[0], v0[1]); w.y = cvt_pk_bf16(v0[2], v0[3]); w.z = cvt_pk_bf16(v1[0], v1[1]); w.w = cvt_pk_bf16(v1[2], v1[3]);
                    *(u32x4*)(UP + (size_t)row * UPW + col) = w;
                }
            }
    }
};

__device__ __forceinline__ void transpose_item(const float* W, int K, int N, bf16_t* WT, const float* g, bool ropeperm, LAS float* scr, int item, int lane, int ldk = 0, int koff = 0) {
    if (ldk == 0) ldk = K;
    const int nblk = N / 64, kb = item / nblk, nb = item % nblk, k0 = 64 * kb, n0 = 64 * nb;
    int sn = n0 + lane;
    if (ropeperm && sn < 2048) sn = (sn & ~63) + ((sn & 63) >> 1) + 32 * (sn & 1);
    float wv[64];
#pragma unroll
    for (int kk = 0; kk < 64; ++kk) wv[kk] = W[(size_t)(k0 + kk) * N + sn];
    if (g) {
#pragma unroll
        for (int kk = 0; kk < 64; kk += 4) { const f32x4 gg = *(const f32x4*)(g + k0 + kk); wv[kk] *= gg[0]; wv[kk + 1] *= gg[1]; wv[kk + 2] *= gg[2]; wv[kk + 3] *= gg[3]; }
    }
#pragma unroll
    for (int kk = 0; kk < 64; ++kk) scr[kk * 65 + lane] = wv[kk];
    asm volatile("s_waitcnt lgkmcnt(0)" ::: "memory");
    const int c = lane & 7;
#pragma unroll
    for (int j = 0; j < 8; ++j) { const int n = (lane >> 3) + 8 * j; const LAS float* s = scr + (8 * c) * 65 + n;
        u32x4 o; o.x = pk2(s[0 * 65], s[1 * 65]); o.y = pk2(s[2 * 65], s[3 * 65]); o.z = pk2(s[4 * 65], s[5 * 65]); o.w = pk2(s[6 * 65], s[7 * 65]);
        *(u32x4*)(WT + (size_t)(n0 + n) * ldk + koff + k0 + 8 * c) = o; }
    asm volatile("s_waitcnt lgkmcnt(0)" ::: "memory");
}

constexpr int AT_KB = 64 * 272, AT_VB = 64 * 320, AT_BUF = AT_KB + AT_VB;
__device__ __forceinline__ void attn_stage(LAS unsigned char* lds, int bufoff, const bf16_t* Kg, const bf16_t* Vg, int wid, int lane) {
#pragma unroll
    for (int i = 0; i < 5; ++i) {
        const int pc = wid + 8 * i;
        if (pc < 37) {
            const bool isk = pc < 17; const int o = (isk ? pc : pc - 17) * 1024 + lane * 16;
            const int pitch = isk ? 272 : 320; const int row = o / pitch; int ch = (o - row * pitch) >> 4; if (ch > 15) ch = 0;
            const bf16_t* src = (isk ? Kg : Vg) + (unsigned)(row * 1024 + ch * 8);
            __builtin_amdgcn_global_load_lds((const unsigned*)src, (LAS unsigned*)(lds + bufoff + (isk ? 0 : AT_KB) + (isk ? pc : pc - 17) * 1024), 16, 0, 0);
        }
    }
}
__device__ __forceinline__ s16x4 vtr(const LAS unsigned char* p) { typedef short v4i16_t __attribute__((ext_vector_type(4))); return __builtin_bit_cast(s16x4, __builtin_amdgcn_ds_read_tr16_b64_v4i16((LAS v4i16_t*)p)); }

__device__ __forceinline__ void softmax_step(f32x16& s, float& m, float& l, f32x16 (&o)[4], bf16x8 (&pk)[2]) {
    float a = fmaxf(fmaxf(s[0], s[1]), s[2]), b = fmaxf(fmaxf(s[3], s[4]), s[5]);
    a = fmaxf(fmaxf(a, s[6]), s[7]); b = fmaxf(fmaxf(b, s[8]), s[9]);
    a = fmaxf(fmaxf(a, s[10]), s[11]); b = fmaxf(fmaxf(b, s[12]), s[13]);
    a = fmaxf(fmaxf(a, s[14]), s[15]);
    const float mx = swap_max(fmaxf(a, b));
    if (__any(mx > m + 8.0f)) {
        const float mn = fmaxf(m, mx);
        const float alpha = __builtin_amdgcn_exp2f(m - mn);
#pragma unroll
        for (int d = 0; d < 4; ++d)
#pragma unroll
            for (int r = 0; r < 16; ++r) o[d][r] *= alpha;
        l *= alpha; m = mn;
    }
    float sum = 0.f;
#pragma unroll
    for (int r = 0; r < 16; ++r) { s[r] = __builtin_amdgcn_exp2f(s[r] - m); sum += s[r]; }
    l += sum;
#pragma unroll
    for (int ks = 0; ks < 2; ++ks) {
        u32x4 w; w.x = cvt_pk_bf16(s[8 * ks + 0], s[8 * ks + 1]); w.y = cvt_pk_bf16(s[8 * ks + 2], s[8 * ks + 3]); w.z = cvt_pk_bf16(s[8 * ks + 4], s[8 * ks + 5]); w.w = cvt_pk_bf16(s[8 * ks + 6], s[8 * ks + 7]);
        pk[ks] = __builtin_bit_cast(bf16x8, w);
    }
}

__device__ __forceinline__ void softmax_step64(f32x16& sa, f32x16& sb, float& m, float& l, f32x16 (&o)[4], bf16x8 (&pk)[4]) {
    float a = fmaxf(fmaxf(sa[0], sa[1]), sa[2]), b = fmaxf(fmaxf(sb[0], sb[1]), sb[2]);
#pragma unroll
    for (int r = 3; r < 15; r += 2) { a = fmaxf(fmaxf(a, sa[r]), sa[r + 1]); b = fmaxf(fmaxf(b, sb[r]), sb[r + 1]); }
    a = fmaxf(a, sa[15]); b = fmaxf(b, sb[15]);
    const float mx = swap_max(fmaxf(a, b));
    if (__any(mx > m + 8.0f)) {
        const float mn = fmaxf(m, mx);
        const float alpha = __builtin_amdgcn_exp2f(m - mn);
#pragma unroll
        for (int d = 0; d < 4; ++d)
#pragma unroll
            for (int r = 0; r < 16; ++r) o[d][r] *= alpha;
        l *= alpha; m = mn;
    }
    float sum = 0.f;
#pragma unroll
    for (int r = 0; r < 16; ++r) { sa[r] = __builtin_amdgcn_exp2f(sa[r] - m); sb[r] = __builtin_amdgcn_exp2f(sb[r] - m); sum += sa[r] + sb[r]; }
    l += sum;
#pragma unroll
    for (int ks = 0; ks < 2; ++ks) {
        u32x4 w; w.x = cvt_pk_bf16(sa[8 * ks + 0], sa[8 * ks + 1]); w.y = cvt_pk_bf16(sa[8 * ks + 2], sa[8 * ks + 3]); w.z = cvt_pk_bf16(sa[8 * ks + 4], sa[8 * ks + 5]); w.w = cvt_pk_bf16(sa[8 * ks + 6], sa[8 * ks + 7]);
        pk[ks] = __builtin_bit_cast(bf16x8, w);
        u32x4 v; v.x = cvt_pk_bf16(sb[8 * ks + 0], sb[8 * ks + 1]); v.y = cvt_pk_bf16(sb[8 * ks + 2], sb[8 * ks + 3]); v.z = cvt_pk_bf16(sb[8 * ks + 4], sb[8 * ks + 5]); v.w = cvt_pk_bf16(sb[8 * ks + 6], sb[8 * ks + 7]);
        pk[2 + ks] = __builtin_bit_cast(bf16x8, v);
    }
}
__device__ __forceinline__ void attn_item(LAS unsigned char* lds, const bf16_t* QB, const bf16_t* KB, const bf16_t* VB, bf16_t* AT, int tb, int h, int qb, int L, float lam, const float* subln) {
    int tid = threadIdx.x; asm volatile("" : "+v"(tid));
    const int lane = tid & 63, r32 = lane & 31, hi = lane >> 5; const int wid = __builtin_amdgcn_readfirstlane(tid >> 6);
    const int tokq = tb + qb * 256 + wid * 32 + r32;
    LAS unsigned char* qs = lds + 2 * AT_BUF + wid * 8704 + r32 * 272 + hi * 16;
#pragma unroll
    for (int mp = 0; mp < 2; ++mp)
#pragma unroll
        for (int d0 = 0; d0 < 4; ++d0) *(LAS bf16x8*)(qs + mp * 128 + d0 * 32) = *(const bf16x8*)(QB + (size_t)tokq * 1024 + h * 128 + mp * 64 + d0 * 16 + hi * 8);
    f32x16 o0[4], o1[4];
#pragma unroll
    for (int d = 0; d < 4; ++d)
#pragma unroll
        for (int r = 0; r < 16; ++r) { o0[d][r] = 0.f; o1[d][r] = 0.f; }
    float m0 = -INFINITY, m1 = -INFINITY, l0 = 0.f, l1 = 0.f;
    const bf16_t* Kh = KB + (size_t)tb * 1024 + h * 128; const bf16_t* Vh = VB + (size_t)tb * 1024 + h * 128;
    const int NT = L / 64;
    const int qd = (lane & 15) >> 2, pp = lane & 3, blk = (lane >> 4) & 1;
    const int koff = r32 * 272 + hi * 16;
    const int voff = AT_KB + (4 * hi + qd) * 320 + (16 * blk + 4 * pp) * 2;
    bf16x8 pk0[4], pk1[4];
#define AT_S64(cbuf, MP, MM, LL, OO, PK) do { \
        const LAS unsigned char* kp = lds + (cbuf) + koff + (MP) * 128; \
        bf16x8 qa[4], ka[4], kb[4]; \
        f32x16 sa, sb; _Pragma("unroll") for (int r = 0; r < 16; ++r) { sa[r] = 0.f; sb[r] = 0.f; } \
        _Pragma("unroll") for (int d0 = 0; d0 < 2; ++d0) { qa[d0] = *(const LAS bf16x8*)(qs + (MP) * 128 + d0 * 32); ka[d0] = *(const LAS bf16x8*)(kp + d0 * 32); kb[d0] = *(const LAS bf16x8*)(kp + 32 * 272 + d0 * 32); } \
        __builtin_amdgcn_sched_barrier(0); \
        _Pragma("unroll") for (int d0 = 0; d0 < 2; ++d0) { \
            sa = __builtin_amdgcn_mfma_f32_32x32x16_bf16(ka[d0], qa[d0], sa, 0, 0, 0); \
            sb = __builtin_amdgcn_mfma_f32_32x32x16_bf16(kb[d0], qa[d0], sb, 0, 0, 0); } \
        _Pragma("unroll") for (int d0 = 2; d0 < 4; ++d0) { qa[d0] = *(const LAS bf16x8*)(qs + (MP) * 128 + d0 * 32); ka[d0] = *(const LAS bf16x8*)(kp + d0 * 32); kb[d0] = *(const LAS bf16x8*)(kp + 32 * 272 + d0 * 32); } \
        __builtin_amdgcn_sched_barrier(0); \
        _Pragma("unroll") for (int d0 = 2; d0 < 4; ++d0) { \
            sa = __builtin_amdgcn_mfma_f32_32x32x16_bf16(ka[d0], qa[d0], sa, 0, 0, 0); \
            sb = __builtin_amdgcn_mfma_f32_32x32x16_bf16(kb[d0], qa[d0], sb, 0, 0, 0); } \
        __builtin_amdgcn_sched_barrier(0); \
        softmax_step64(sa, sb, MM, LL, OO, PK); \
        __builtin_amdgcn_sched_barrier(0); } while (0)
#define AT_PV64(cbuf, sub) do { \
        const LAS unsigned char* vp = lds + (cbuf) + voff + (sub) * 32 * 320; \
        _Pragma("unroll") for (int hh = 0; hh < 2; ++hh) { \
            s16x4 vlo[4], vhi[4]; \
            _Pragma("unroll") for (int i2 = 0; i2 < 4; ++i2) { const int i = 4 * hh + i2; vlo[i2] = vtr(vp + (i & 1) * 16 * 320 + (i >> 1) * 64); vhi[i2] = vtr(vp + (i & 1) * 16 * 320 + 8 * 320 + (i >> 1) * 64); } \
            __builtin_amdgcn_sched_barrier(0); \
            _Pragma("unroll") for (int i2 = 0; i2 < 4; ++i2) { const int i = 4 * hh + i2; \
                const bf16x8 vf = (bf16x8){vlo[i2][0], vlo[i2][1], vlo[i2][2], vlo[i2][3], vhi[i2][0], vhi[i2][1], vhi[i2][2], vhi[i2][3]}; \
                o0[i >> 1] = __builtin_amdgcn_mfma_f32_32x32x16_bf16(vf, pk0[2 * (sub) + (i & 1)], o0[i >> 1], 0, 0, 0); \
                o1[i >> 1] = __builtin_amdgcn_mfma_f32_32x32x16_bf16(vf, pk1[2 * (sub) + (i & 1)], o1[i >> 1], 0, 0, 0); } \
            __builtin_amdgcn_sched_barrier(0); } } while (0)
    attn_stage(lds, 0, Kh, Vh, wid, lane);
    asm volatile("s_waitcnt vmcnt(0)" ::: "memory"); __syncthreads();
    for (int t = 0; t < NT; ++t) {
        const int cb = (t & 1) * AT_BUF;
        if (t + 1 < NT) attn_stage(lds, AT_BUF - cb, Kh + (size_t)(t + 1) * 64 * 1024, Vh + (size_t)(t + 1) * 64 * 1024, wid, lane);
        AT_S64(cb, 0, m0, l0, o0, pk0);
        AT_S64(cb, 1, m1, l1, o1, pk1);
        AT_PV64(cb, 0);
        AT_PV64(cb, 1);
        asm volatile("s_waitcnt vmcnt(0)" ::: "memory"); __syncthreads();
    }
#undef AT_S64
#undef AT_PV64
    int tq2 = tb + qb * 256 + wid * 32 + r32; asm volatile("" : "+v"(tq2));
    l0 = swap_add(l0); l1 = swap_add(l1);
    const float i0 = 1.0f / l0, i1 = __uint_as_float((unsigned)__builtin_amdgcn_readfirstlane((int)__float_as_uint(lam))) / l1;
    float ss = 0.f;
#pragma unroll
    for (int d = 0; d < 4; ++d)
#pragma unroll
        for (int r = 0; r < 16; ++r) { const float a = o0[d][r] * i0 - o1[d][r] * i1; o0[d][r] = a; ss += a * a; }
    ss = swap_add(ss);
    const float rs = rsqrtf(ss * (1.0f / 128.0f) + EPS) * (1.0f - LAMBDA_INIT);
    bf16_t* orow = AT + (size_t)tq2 * 2048 + h * 128;
#pragma unroll
    for (int d = 0; d < 4; ++d)
#pragma unroll
        for (int g = 0; g < 4; ++g) {
            const int dd = 32 * d + 8 * g + 4 * hi;
            const f32x4 gg = *(const f32x4*)(subln + dd);
            u32x2 w; w.x = cvt_pk_bf16(o0[d][4 * g + 0] * rs * gg[0], o0[d][4 * g + 1] * rs * gg[1]); w.y = cvt_pk_bf16(o0[d][4 * g + 2] * rs * gg[2], o0[d][4 * g + 3] * rs * gg[3]);
            *(u32x2*)(orow + dd) = w;
        }
}

constexpr int HY_F1 = 32832, HY_U = 66048;
__device__ __forceinline__ void hyena_item(LAS unsigned char* lds, const bf16_t* FILT  , const bf16_t* XTp, const float* cw, const float* cb, bf16_t* YT, int c, int L) {
    int tid = threadIdx.x; asm volatile("" : "+v"(tid));
    const int lane = tid & 63, r32 = lane & 31, hi = lane >> 5; const int wid = __builtin_amdgcn_readfirstlane(tid >> 6);
    const int NB = L >> 5, B = CH / L, G = 32 / B, gsh = (B == 2) ? 4 : 3, APAD = 4 * G, NBP = NB + 8 * G + 4, QP = NBP >> 2, BS = 16 * QP + 8;
    __syncthreads();
    {
        const int npc = (2 * L * 2) / 16;
        const u32x4* src = (const u32x4*)(FILT + (size_t)c * 4 * L);
        for (int q = tid; q < 2 * npc; q += 512) {
            const int cp = q >= npc; const int qq = cp ? q - npc : q;
            *(LAS u32x4*)(lds + (cp ? HY_F1 : 0) + qq * 16) = src[q];
        }
        const bf16_t* x1t = XTp + (size_t)c * CH; const bf16_t* hvt = XTp + (size_t)(1024 + c) * CH;
        const float wx0 = cw[1024 + c], wx1 = cw[3072 + 1024 + c], wx2 = cw[6144 + 1024 + c], bx = cb[1024 + c];
        const float wh0 = cw[2048 + c], wh1 = cw[3072 + 2048 + c], wh2 = cw[6144 + 2048 + c], bh = cb[2048 + c];
        for (int q = tid; q < CH / 8; q += 512) {
            const int tk = q * 8, b = tk / L, pos = tk - b * L, a = pos >> 5, r = (pos >> 3) & 3;
            const u32x4 xw = *(const u32x4*)(x1t + tk), hw = *(const u32x4*)(hvt + tk);
            const float px = pos > 0 ? bf2f(x1t[tk - 1]) : 0.f, ph = pos > 0 ? bf2f(hvt[tk - 1]) : 0.f;
            const float nx = pos + 8 < L ? bf2f(x1t[tk + 8]) : 0.f, nh = pos + 8 < L ? bf2f(hvt[tk + 8]) : 0.f;
            float xs[10], hs[10];
            xs[0] = px; xs[1] = bflo(xw.x); xs[2] = bfhi(xw.x); xs[3] = bflo(xw.y); xs[4] = bfhi(xw.y); xs[5] = bflo(xw.z); xs[6] = bfhi(xw.z); xs[7] = bflo(xw.w); xs[8] = bfhi(xw.w); xs[9] = nx;
            hs[0] = ph; hs[1] = bflo(hw.x); hs[2] = bfhi(hw.x); hs[3] = bflo(hw.y); hs[4] = bfhi(hw.y); hs[5] = bflo(hw.z); hs[6] = bfhi(hw.z); hs[7] = bflo(hw.w); hs[8] = bfhi(hw.w); hs[9] = nh;
            float u[8];
#pragma unroll
            for (int e = 0; e < 8; ++e) u[e] = (wx0 * xs[e] + wx1 * xs[e + 1] + wx2 * xs[e + 2] + bx) * (wh0 * hs[e] + wh1 * hs[e + 1] + wh2 * hs[e + 2] + bh);
            u32x4 uw; uw.x = cvt_pk_bf16(u[0], u[1]); uw.y = cvt_pk_bf16(u[2], u[3]); uw.z = cvt_pk_bf16(u[4], u[5]); uw.w = cvt_pk_bf16(u[6], u[7]);
            { const int idx = APAD + a; *(LAS u32x4*)(lds + HY_U + (b * BS + (r * 4 + (idx & 3)) * QP + (idx >> 2)) * 16) = uw; }
        }
        const int npad = 8 * G + 4, nz = 4 * B * npad;
        for (int z = tid; z < nz; z += 512) {
            const int plane = z / npad, w_ = z - plane * npad; const int idx = (w_ < APAD) ? w_ : NB + w_;
            *(LAS u32x4*)(lds + HY_U + ((plane >> 2) * BS + ((plane & 3) * 4 + (idx & 3)) * QP + (idx >> 2)) * 16) = zero4();
        }
    }
    __syncthreads();
    {
    const int wq = wid & 3, half = wid >> 2;
    f32x16 acc0, acc1, acc2, acc3;
#pragma unroll
    for (int r = 0; r < 16; ++r) { acc0[r] = 0.f; acc1[r] = 0.f; acc2[r] = 0.f; acc3[r] = 0.f; }
    const int bn = r32 >> gsh, iblk = r32 & (G - 1);
    const int Ib = G * 4 * wq;
    const int dlo_all = Ib - NB + 1, dhi_all = Ib + 4 * G - 1, dmid = dlo_all + ((dhi_all - dlo_all + 1) >> 1);
    const int dlo = half ? dmid : dlo_all, dhi = half ? dhi_all : dmid - 1;
#define HY_LOADA(P, DL) do { \
        _Pragma("unroll") for (int kh = 0; kh < 2; ++kh) { \
            const int x0 = L - 32 * (DL) + 16 * kh + 8 * hi - r32; const int cp = x0 & 1; const int xe = x0 - cp; \
            const LAS unsigned* fp = (const LAS unsigned*)(lds + (cp ? HY_F1 : 0)) + (xe >> 1); \
            P##a[kh].x = fp[0]; P##a[kh].y = fp[1]; P##a[kh].z = fp[2]; P##a[kh].w = fp[3]; } } while (0)
#define HY_LOADB(P, DL) do { \
        const int ix = Ib + APAD - (DL); \
        _Pragma("unroll") for (int kh = 0; kh < 2; ++kh) \
            P##b[kh] = *(const LAS u32x4*)(lds + HY_U + (bn * BS + ((2 * kh + hi) * 4 + (ix & 3)) * QP + (ix >> 2) + iblk) * 16); } while (0)
#define HY_CL(x) ((x) <= dhi ? (x) : dhi)
#define HY_LD(P, DL) do { const int d_ = HY_CL(DL); HY_LOADA(P, d_); HY_LOADB(P, d_); } while (0)
#define HY_MMA4(P, Q1, Q2, Q3) do { \
        _Pragma("unroll") for (int kh = 0; kh < 2; ++kh) { \
            acc0 = __builtin_amdgcn_mfma_f32_32x32x16_bf16(__builtin_bit_cast(bf16x8, P##a[kh]), __builtin_bit_cast(bf16x8, P##b[kh]), acc0, 0, 0, 0); \
            acc1 = __builtin_amdgcn_mfma_f32_32x32x16_bf16(__builtin_bit_cast(bf16x8, P##a[kh]), __builtin_bit_cast(bf16x8, Q1##b[kh]), acc1, 0, 0, 0); \
            acc2 = __builtin_amdgcn_mfma_f32_32x32x16_bf16(__builtin_bit_cast(bf16x8, P##a[kh]), __builtin_bit_cast(bf16x8, Q2##b[kh]), acc2, 0, 0, 0); \
            acc3 = __builtin_amdgcn_mfma_f32_32x32x16_bf16(__builtin_bit_cast(bf16x8, P##a[kh]), __builtin_bit_cast(bf16x8, Q3##b[kh]), acc3, 0, 0, 0); } } while (0)
#define HY_SB() __builtin_amdgcn_sched_barrier(0)
    u32x4 P0a[2], P0b[2], P1a[2], P1b[2], P2a[2], P2b[2], P3a[2], P3b[2], P4a[2], P4b[2];
    HY_LOADB(P4, dlo - 1); HY_LOADB(P3, dlo - 2); HY_LOADB(P2, dlo - 3);
    HY_LD(P0, dlo);
    int dl = dlo;
    for (; dl + 4 <= dhi; dl += 5) {
        HY_SB(); HY_LD(P1, dl + 1); HY_SB(); HY_MMA4(P0, P4, P3, P2);
        HY_SB(); HY_LD(P2, dl + 2); HY_SB(); HY_MMA4(P1, P0, P4, P3);
        HY_SB(); HY_LD(P3, dl + 3); HY_SB(); HY_MMA4(P2, P1, P0, P4);
        HY_SB(); HY_LD(P4, dl + 4); HY_SB(); HY_MMA4(P3, P2, P1, P0);
        HY_SB(); HY_LD(P0, dl + 5); HY_SB(); HY_MMA4(P4, P3, P2, P1);
    }
    HY_SB();
    if (dl <= dhi)     { HY_LD(P1, dl + 1); HY_MMA4(P0, P4, P3, P2); }
    if (dl + 1 <= dhi) { HY_LD(P2, dl + 2); HY_MMA4(P1, P0, P4, P3); }
    if (dl + 2 <= dhi) { HY_LD(P3, dl + 3); HY_MMA4(P2, P1, P0, P4); }
    if (dl + 3 <= dhi) { HY_MMA4(P3, P2, P1, P0); }
#undef HY_LOADA
#undef HY_LOADB
#undef HY_CL
#undef HY_LD
#undef HY_MMA4
#undef HY_SB
    __syncthreads();
    LAS float* stash = (LAS float*)lds + (wq * 64) * 64 + lane;
    if (half) {
#pragma unroll
        for (int r = 0; r < 16; ++r) { stash[(r) * 64] = acc0[r]; stash[(16 + r) * 64] = acc1[r]; stash[(32 + r) * 64] = acc2[r]; stash[(48 + r) * 64] = acc3[r]; }
    }
    __syncthreads();
    if (!half) {
#pragma unroll
        for (int r = 0; r < 16; ++r) { acc0[r] += stash[(r) * 64]; acc1[r] += stash[(16 + r) * 64]; acc2[r] += stash[(32 + r) * 64]; acc3[r] += stash[(48 + r) * 64]; }
        bf16_t* yb = YT + (size_t)c * CH + bn * L + 32 * (Ib + 4 * iblk) + 4 * hi;
#pragma unroll
        for (int g = 0; g < 4; ++g) {
            u32x2 w;
            w.x = cvt_pk_bf16(acc0[4 * g + 0], acc0[4 * g + 1]); w.y = cvt_pk_bf16(acc0[4 * g + 2], acc0[4 * g + 3]); *(u32x2*)(yb + 8 * g) = w;
            w.x = cvt_pk_bf16(acc1[4 * g + 0], acc1[4 * g + 1]); w.y = cvt_pk_bf16(acc1[4 * g + 2], acc1[4 * g + 3]); *(u32x2*)(yb + 32 + 8 * g) = w;
            w.x = cvt_pk_bf16(acc2[4 * g + 0], acc2[4 * g + 1]); w.y = cvt_pk_bf16(acc2[4 * g + 2], acc2[4 * g + 3]); *(u32x2*)(yb + 64 + 8 * g) = w;
            w.x = cvt_pk_bf16(acc3[4 * g + 0], acc3[4 * g + 1]); w.y = cvt_pk_bf16(acc3[4 * g + 2], acc3[4 * g + 3]); *(u32x2*)(yb + 96 + 8 * g) = w;
        }
    }
    }
}

__device__ __forceinline__ void conv8(const bf16_t* src, int pitch, bool hasp, bool hasn, const float* w, int C, const float* b, float (&o)[8]) {
    const u32x4 z = zero4();
    const u32x4 cu = *(const u32x4*)src; const u32x4 pv = hasp ? *(const u32x4*)(src - pitch) : z; const u32x4 nx = hasn ? *(const u32x4*)(src + pitch) : z;
    const f32x4 w0a = *(const f32x4*)(w), w0b = *(const f32x4*)(w + 4), w1a = *(const f32x4*)(w + C), w1b = *(const f32x4*)(w + C + 4), w2a = *(const f32x4*)(w + 2 * C), w2b = *(const f32x4*)(w + 2 * C + 4);
    const f32x4 ba = *(const f32x4*)b, bb = *(const f32x4*)(b + 4);
    o[0] = w0a[0] * bflo(pv.x) + w1a[0] * bflo(cu.x) + w2a[0] * bflo(nx.x) + ba[0];
    o[1] = w0a[1] * bfhi(pv.x) + w1a[1] * bfhi(cu.x) + w2a[1] * bfhi(nx.x) + ba[1];
    o[2] = w0a[2] * bflo(pv.y) + w1a[2] * bflo(cu.y) + w2a[2] * bflo(nx.y) + ba[2];
    o[3] = w0a[3] * bfhi(pv.y) + w1a[3] * bfhi(cu.y) + w2a[3] * bfhi(nx.y) + ba[3];
    o[4] = w0b[0] * bflo(pv.z) + w1b[0] * bflo(cu.z) + w2b[0] * bflo(nx.z) + bb[0];
    o[5] = w0b[1] * bfhi(pv.z) + w1b[1] * bfhi(cu.z) + w2b[1] * bfhi(nx.z) + bb[1];
    o[6] = w0b[2] * bflo(pv.w) + w1b[2] * bflo(cu.w) + w2b[2] * bflo(nx.w) + bb[2];
    o[7] = w0b[3] * bfhi(pv.w) + w1b[3] * bfhi(cu.w) + w2b[3] * bfhi(nx.w) + bb[3];
}


#define XB_TMO      128
#define XB_XCNT(j)  (256  + 64 * (j))
#define XB_XSUB(j)  (1280 + 64 * (j))
#define XB_XGEN(j)  (2304 + 64 * (j))
#define XB_TOP      3328
#define XB_TOPGEN   3392
#define XCD_BAR_WORDS 3456
#define XB_SPIN_CAP (1u << 18)
__device__ __forceinline__ unsigned xb_ld(unsigned* p)              { return __hip_atomic_load(p, __ATOMIC_RELAXED, __HIP_MEMORY_SCOPE_AGENT); }
__device__ __forceinline__ unsigned xb_add(unsigned* p, unsigned v) { return __hip_atomic_fetch_add(p, v, __ATOMIC_RELAXED, __HIP_MEMORY_SCOPE_AGENT); }
__device__ __forceinline__ unsigned xb_xcc_id() { return (unsigned)__builtin_amdgcn_s_getreg((3 << 11) | 20) & 0xFu; }
#define XB_SPIN(cond, bar) do { unsigned _sp = 0; while (cond) { __builtin_amdgcn_s_sleep(1); \
    if ((++_sp & 255u) == 0u) { if (xb_ld(&(bar)[XB_TMO])) break; if (_sp > XB_SPIN_CAP) { atomicAdd(&(bar)[XB_TMO], 1u); break; } } } } while (0)
__device__ __forceinline__ void xcd_barrier_complete(unsigned* bar, unsigned x, unsigned& nloc, unsigned& nx) {
    const unsigned G = gridDim.x * gridDim.y * gridDim.z;
    unsigned sum, cnt, mine, sp = 0u;
    for (;;) {
        sum = 0u; cnt = 0u; mine = 0u;
#pragma unroll
        for (unsigned j = 0; j < 16; ++j) { const unsigned c = xb_ld(&bar[XB_XCNT(j)]); sum += c; cnt += (c > 0u) ? 1u : 0u; mine = (j == x) ? c : mine; }
        if (sum == G) break;
        __builtin_amdgcn_s_sleep(1);
        if ((++sp & 255u) == 0u) { if (xb_ld(&bar[XB_TMO])) break; if (sp > XB_SPIN_CAP) { atomicAdd(&bar[XB_TMO], 1u); break; } }
    }
    nloc = mine > 0u ? mine : 1u; nx = cnt > 0u ? cnt : 1u;
}
__device__ __forceinline__ void xcd_barrier(unsigned* bar, volatile LAS unsigned* st) {
    asm volatile("s_waitcnt vmcnt(0)" ::: "memory");
    __syncthreads();
    if (threadIdx.x == 0) {
        const unsigned x = xb_xcc_id();
        __builtin_amdgcn_s_waitcnt(0);
        unsigned nloc = st[0], nx = st[1];
        if (nloc == 0u) { xcd_barrier_complete(bar, x, nloc, nx); st[0] = nloc; st[1] = nx; }
        const unsigned old = xb_add(&bar[XB_XSUB(x)], 1u);
        const unsigned gen = old / nloc;
        if (old + 1u == (gen + 1u) * nloc) {
            __builtin_amdgcn_fence(__ATOMIC_RELEASE, "agent");
            asm volatile("s_waitcnt vmcnt(0)" ::: "memory");
            const unsigned og = xb_add(&bar[XB_TOP], 1u);
            const unsigned tg = og / nx;
            if (og + 1u == (tg + 1u) * nx) xb_add(&bar[XB_TOPGEN], 1u);
            else XB_SPIN(xb_ld(&bar[XB_TOPGEN]) == tg, bar);
            __builtin_amdgcn_fence(__ATOMIC_ACQUIRE, "agent");
            xb_add(&bar[XB_XGEN(x)], 1u);
            asm volatile("s_waitcnt vmcnt(0)" ::: "memory");
        } else {
            XB_SPIN(xb_ld(&bar[XB_XGEN(x)]) == gen, bar);
            __builtin_amdgcn_fence(__ATOMIC_ACQUIRE, "agent");
            asm volatile("s_waitcnt vmcnt(0)" ::: "memory");
        }
    }
    __syncthreads();
}

#ifndef PHMASK
#define PHMASK 0xFFFFu
#endif
#ifndef REPMASK
#define REPMASK 0u
#endif
#define MISC_OFF 147392
#define GSYNC() do { kparams_t KPb = kparams(); xcd_barrier((unsigned*)(KPb->ws + WS_CTL), (volatile LAS unsigned*)(lds + MISC_OFF)); } while (0)
#define REPS(k) for (int rep_ = 0; rep_ < 1 + (int)((REPMASK >> (k)) & 1u); ++rep_)
constexpr int LDS_BYTES = 147456;
typedef const __attribute__((address_space(4))) Params* kparams_t;
__device__ __forceinline__ kparams_t kparams() { kparams_t p = (kparams_t)__builtin_amdgcn_kernarg_segment_ptr(); asm volatile("" : "+s"(p)); return p; }
#define PIN(i) ((const float*)KP->in[i])
__device__ __forceinline__ const float* xin_ptr(kparams_t KP, int chunk) { int c = chunk; asm volatile("" : "+s"(c)); return c == 0 ? (const float*)KP->in[0] : (const float*)KP->in[1] + ((size_t)(c - 1) << 25); }
__device__ __forceinline__ float* outc_ptr(kparams_t KP, int chunk) { int c = chunk; asm volatile("" : "+s"(c)); return (float*)KP->out + ((size_t)c << 25); }
#define WSB(off) ((bf16_t*)(ws + (off)))
#define WSF(off) ((float*)(ws + (off)))
#define PHASE_BEGIN kparams_t KP = kparams(); unsigned char* ws = KP->ws; (void)ws; int tid = threadIdx.x; asm volatile("" : "+v"(tid)); const int lane = tid & 63; const int wid = __builtin_amdgcn_readfirstlane(tid >> 6); const int gw = bid * 8 + wid; (void)lane; (void)gw;
#define PART1 WSF(WS_PART1)
#define PART2 WSF(WS_PART2)
#define RSTD1 WSF(WS_RSTD1)
#define ROPE ((f32x2*)(ws + WS_ROPE))
#define H3 WSF(WS_H3)
#define WIN WSB(WS_WIN)
#define WUP WSB(WS_WUP)
#define WDN WSB(WS_WDN)
#define WOUT WSB(WS_WOUT)
#define WA WSB(WS_WA)
#define WH WSB(WS_WH)
#define F4 WSB(WS_F4)
#define F8 WSB(WS_F8)
#define XB WSB(WS_XB)
#define MG WSB(WS_R23)
#define X1B WSB(WS_R1 + R1_UT)
#define X2B WSB(WS_R1 + R1_UT)
#define ACT WSB(WS_R23)
#define QB WSB(WS_R1 + R1_QB)
#define KB WSB(WS_R1 + R1_KB)
#define VB WSB(WS_R1 + R1_VB)
#define HY WSB(WS_R1 + R1_HY)
#define GT WSB(WS_R1 + R1_GT)
#define AT WSB(WS_R1 + R1_AT)
#define HN WSB(WS_R1 + R1_HN)
#define UT WSB(WS_R1 + R1_UT)
#define YT WSB(WS_R1 + R1_YT)
#define XT WSB(WS_R1 + R1_XT)
#define T1 WSB(WS_R1 + R1_QB)
#define UP WSB(WS_R1 + R1_QB)
#define BODY_PA(CK) do { const float* xin_ = xin_ptr(KP, (CK)); \
        for (int row = gw; row < CH; row += NGW) { \
            const f32x4* xr = (const f32x4*)(xin_ + (size_t)row * DM) + lane; \
            f32x4 v[8]; float s = 0.f; \
            _Pragma("unroll") for (int j = 0; j < 8; ++j) { v[j] = __builtin_nontemporal_load(xr + 64 * j); s += (v[j][0] * v[j][0] + v[j][1] * v[j][1]) + (v[j][2] * v[j][2] + v[j][3] * v[j][3]); } \
            s = wave_sum(s, lane); \
            if (lane == 0) RSTD1[row] = rsqrtf(s * (1.0f / DM) + EPS); \
            u32x2* o = (u32x2*)(XB + (size_t)row * DM) + lane; \
            _Pragma("unroll") for (int j = 0; j < 8; ++j) { u32x2 w; w.x = cvt_pk_bf16(v[j][0], v[j][1]); w.y = cvt_pk_bf16(v[j][2], v[j][3]); o[64 * j] = w; } \
        } } while (0)
#define BODY_FINAL(CK) do { const float* nf = PIN(29); float* outc_ = outc_ptr(KP, (CK)); \
        for (int row = gw; row < CH; row += NGW) { \
            float s = (lane < 32) ? PART2[(size_t)row * 32 + lane] : 0.f; \
            s = wave_sum(s, lane); \
            const float rs = rsqrtf(s * (1.0f / DM) + EPS); \
            const u32x4* xr = (const u32x4*)(X2B + (size_t)row * DM) + lane; f32x4* orow = (f32x4*)(outc_ + (size_t)row * DM); const f32x4* gr = (const f32x4*)nf; \
            _Pragma("unroll") for (int j = 0; j < 4; ++j) { \
                const u32x4 w = xr[64 * j]; const int e4 = 2 * (lane + 64 * j); \
                const f32x4 g0 = gr[e4], g1 = gr[e4 + 1]; \
                __builtin_nontemporal_store((f32x4){bflo(w.x) * rs * g0[0], bfhi(w.x) * rs * g0[1], bflo(w.y) * rs * g0[2], bfhi(w.y) * rs * g0[3]}, orow + e4); \
                __builtin_nontemporal_store((f32x4){bflo(w.z) * rs * g1[0], bfhi(w.z) * rs * g1[1], bflo(w.w) * rs * g1[2], bfhi(w.w) * rs * g1[3]}, orow + e4 + 1); \
            } } } while (0)
__global__ void __launch_bounds__(512, 2) mega_fwd(Params P) {
    extern __shared__ __attribute__((aligned(16))) unsigned char lds_raw[];
    LAS unsigned char* lds = (LAS unsigned char*)lds_raw;
    cg::grid_group grid = cg::this_grid();
    const int G = gridDim.x, bid = blockIdx.x;
    const int NGW = G * 8;
    if (threadIdx.x < 2) ((volatile LAS unsigned*)(lds + MISC_OFF))[threadIdx.x] = 0u;
    { kparams_t KPb = kparams(); if (threadIdx.x == 0) (void)xb_add(&((unsigned*)(KPb->ws + WS_CTL))[XB_XCNT(xb_xcc_id())], 1u); }
    __syncthreads();
    if (PHMASK & (1u << 0)) { PHASE_BEGIN
        LAS float* scr = (LAS float*)(lds + wid * 16640);
        constexpr int I_IN = 32 * 160, I_UP = 32 * 176, I_DN = 88 * 32, I_OUT = 32 * 32, I_A = 16 * 32;
        constexpr int NIT = I_IN + I_UP + I_DN + I_OUT + 2 * I_A;
        REPS(0) for (int it = gw; it < NIT; it += NGW) {
            int r = it;
            if (r < I_IN) { transpose_item(PIN(3), DM, INW, WIN, PIN(2), true, scr, r, lane); continue; } r -= I_IN;
            if (r < I_UP) { transpose_item(PIN(25), DM, UPW, WUP, PIN(24), false, scr, r, lane); continue; } r -= I_UP;
            if (r < I_DN) { transpose_item(PIN(28), DFF, DM, WDN, nullptr, false, scr, r, lane); continue; } r -= I_DN;
            if (r < I_OUT) { transpose_item(PIN(23), DM, DM, WOUT, nullptr, false, scr, r, lane); continue; } r -= I_OUT;
            if (r < I_A) { transpose_item(PIN(21), 1024, DM, WA, nullptr, false, scr, r, lane, 2048, 0); continue; } r -= I_A;
            transpose_item(PIN(22), 1024, DM, WA, nullptr, false, scr, r, lane, 2048, 1024);
        }
        REPS(0) for (int e = bid * 512 + tid; e < 8192 * 32; e += G * 512) {
            const int pos = e >> 5, i = e & 31;
            const float inv = (float)exp2(-(double)(2 * i) / 64.0 * 13.287712379549449);
            const float ang = (float)pos * inv;
            double s, c; sincos_d((double)ang, s, c);
            ROPE[e] = (f32x2){(float)c, (float)s};
        }
        const float* w1 = PIN(12); const float* b1 = PIN(13); const float* w2 = PIN(14); const float* b2 = PIN(15); const float* w3 = PIN(16); const float* b3 = PIN(17); const float* fq_ = PIN(19);
        const float fr = fq_[lane];
        REPS(0) for (int it = gw; it < 4096 + 8192; it += NGW) {
            const int L = it < 4096 ? 4096 : 8192, t = it < 4096 ? it : it - 4096;
            const float tn = (float)t / (float)(L - 1);
            const float w = 6.283185307179586f * (float)t / (float)L;
            float z = 0.f;
            if (lane == 0) z = tn;
            else if (lane <= 32) {
                const int k = (lane - 1) & 15;
                const float f = 1e-4f + (float)k * ((15.0f - 1e-4f) / 15.0f);
                double s, c; sincos_d((double)(f * w), s, c);
                z = (lane <= 16) ? (float)c : (float)(-s);
            }
            float a = b1[lane];
#pragma unroll 11
            for (int e = 0; e < 33; ++e) a += __shfl(z, e) * w1[e * 64 + lane];
            float h = sin_f(fr * a);
            a = b2[lane];
#pragma unroll 16
            for (int e = 0; e < 64; ++e) a += __shfl(h, e) * w2[e * 64 + lane];
            h = sin_f(fr * a);
            a = b3[lane];
#pragma unroll 16
            for (int e = 0; e < 64; ++e) a += __shfl(h, e) * w3[e * 64 + lane];
            h = sin_f(fr * a);
            H3[(size_t)it * 64 + lane] = h;
        }
    }
    grid.sync();
    if (PHMASK & (1u << 1)) { PHASE_BEGIN
        const float* w4 = PIN(18); const float* hb = PIN(20);
        const int NI4 = 64 * 256, NI8 = 128 * 256;
        REPS(1) for (int it = gw; it < NI4 + NI8; it += NGW) {
            const bool is8 = it >= NI4; const int L = is8 ? 8192 : 4096; const int r = is8 ? it - NI4 : it;
            const int tb = r >> 8, cg8 = r & 255; const int t = tb * 64 + lane;
            const float* hrow = H3 + (size_t)((is8 ? 4096 : 0) + t) * 64;
            bf16_t* Fb = is8 ? F8 : F4;
            const float tn = (float)t / (float)(L - 1);
            float acc8[8];
#pragma unroll
            for (int cc = 0; cc < 8; ++cc) acc8[cc] = 0.f;
#pragma unroll 2
            for (int jb = 0; jb < 16; ++jb) {
                const f32x4 h4 = *(const f32x4*)(hrow + 4 * jb);
#pragma unroll
                for (int jj = 0; jj < 4; ++jj) {
                    const f32x4 wa = *(const f32x4*)(w4 + (4 * jb + jj) * 2048 + cg8 * 8), wb = *(const f32x4*)(w4 + (4 * jb + jj) * 2048 + cg8 * 8 + 4);
#pragma unroll
                    for (int e = 0; e < 4; ++e) { acc8[e] += h4[jj] * wa[e]; acc8[4 + e] += h4[jj] * wb[e]; }
                }
            }
#pragma unroll
            for (int cc = 0; cc < 8; ++cc) {
                const int cp = cg8 * 8 + cc;
                const float a = acc8[cc];
                const int c = cp & 1023; const bool bwd = cp >= 1024;
                const float mind = -3.0701134573253946f, maxd = -15.350567286626973f;
                const float delta = fabsf(mind + (float)c * ((maxd - mind) / 1023.0f));
                float val = a * __expf(-tn * delta);
                bf16_t* f0 = Fb + (size_t)c * 4 * L; bf16_t* f1 = f0 + 2 * L;
                if (!bwd) { if (t == 0) val += hb[c]; const int x = L - t; const bf16_t v = (bf16_t)f2bf(val); f0[x] = v; f1[x - 1] = v; }
                else if (t > 0) { const int x = L + t; const bf16_t v = (bf16_t)f2bf(val); f0[x] = v; f1[x - 1] = v; }
                else { f0[0] = 0; f1[2 * L - 1] = 0; }
            }
        }
    }

    if (PHMASK & (1u << 2)) { PHASE_BEGIN BODY_PA(0); }
#pragma unroll 1
    for (int chunk = 0; chunk < NCHUNK; ++chunk) {
        const int L = chunk == 0 ? 4096 : 8192;
#define xin xin_ptr(KP, chunk)
#define outc outc_ptr(KP, chunk)
#define FILT (chunk == 0 ? F4 : F8)
        GSYNC();
        if (PHMASK & (1u << 3)) { PHASE_BEGIN
#pragma unroll 1
            for (int step = 0; step < 2; ++step) {
                if ((step == 0) != ((bid & 1) != 0)) {
                    pg8::Gemm g{XB, WIN, CH, INW, DM}; pg8::StaticOrder S; S.init(CH, INW, G, bid);
                    Epi1 E{QB, KB, VB, HY, GT, XT, RSTD1, PIN(6), ROPE, L};
                    REPS(3) pg8::gemm_phase<Epi1, true>(lds, g, S, E);
                } else if (chunk > 0) { BODY_FINAL(chunk - 1); }
            }
        }
        GSYNC();
        if (PHMASK & (1u << 5)) { PHASE_BEGIN
            const int nqb = L / 256;
            float lam;
            { const float a = wave_sum(PIN(7)[lane] * PIN(8)[lane], lane), b = wave_sum(PIN(9)[lane] * PIN(10)[lane], lane); lam = __expf(a) - __expf(b) + LAMBDA_INIT; }
            const int vb = (G == 256) ? ((bid & 7) * 32 + (bid >> 3)) : bid;
            REPS(5) for (int it0 = vb; it0 < 512; it0 += G) {
                const int it = it0; const int nqsh = (L == 4096) ? 4 : 5; const int qb = it & (nqb - 1), sh = it >> nqsh, h = sh & 7, s = sh >> 3;
                attn_item(lds, QB, KB, VB, AT, s * L, h, qb, L, lam, PIN(11));
            }
            REPS(13) for (int c = bid; c < 1024; c += G) hyena_item(lds, FILT, XT, PIN(4), PIN(5), YT, c, L);
            __syncthreads();
        }
        GSYNC();
        if (PHMASK & (1u << 6)) { PHASE_BEGIN
            const float* cw = PIN(4); const float* cb = PIN(5);
            LAS bf16_t* tl = (LAS bf16_t*)lds;
            for (int tix = bid; tix < 4096; tix += G) {
                const int tb = tix >> 4, cbk = tix & 15;
                { const int ch = tid >> 3, seg = tid & 7; *(LAS u32x4*)(tl + ch * 72 + seg * 8) = *(const u32x4*)(YT + (size_t)(cbk * 64 + ch) * CH + tb * 64 + seg * 8); }
                __syncthreads();
                const int tr = tid >> 3, tc = tid & 7; const int tok = tb * 64 + tr, pos = tok & (L - 1), c0 = cbk * 64 + tc * 8;
                float a[8];
                conv8(HY + (size_t)tok * 3072 + c0, 3072, pos > 0, pos < L - 1, cw + c0, 3072, cb + c0, a);
                u32x4 w;
                w.x = cvt_pk_bf16(a[0] * bf2f(tl[(tc * 8 + 0) * 72 + tr]), a[1] * bf2f(tl[(tc * 8 + 1) * 72 + tr]));
                w.y = cvt_pk_bf16(a[2] * bf2f(tl[(tc * 8 + 2) * 72 + tr]), a[3] * bf2f(tl[(tc * 8 + 3) * 72 + tr]));
                w.z = cvt_pk_bf16(a[4] * bf2f(tl[(tc * 8 + 4) * 72 + tr]), a[5] * bf2f(tl[(tc * 8 + 5) * 72 + tr]));
                w.w = cvt_pk_bf16(a[6] * bf2f(tl[(tc * 8 + 6) * 72 + tr]), a[7] * bf2f(tl[(tc * 8 + 7) * 72 + tr]));
                *(u32x4*)(AT + (size_t)tok * 2048 + 1024 + c0) = w;
                __syncthreads();
            }
        }
        GSYNC();
        if (PHMASK & (1u << 7)) { PHASE_BEGIN
            pg8::Gemm g{AT, WA, CH, DM, DM}; pg8::StaticOrder S; S.init(CH, DM, G, bid);
            Epi2M E{GT, MG};
            pg8::gemm_phase<Epi2M, true>(lds, g, S, E);
        }
        GSYNC();
        if (PHMASK & (1u << 8)) { PHASE_BEGIN
            pg8::Gemm g{MG, WOUT, CH, DM, DM}; pg8::StaticOrder S; S.init(CH, DM, G, bid);
            EpiResB E{XB, X1B, PART1};
            pg8::gemm_phase<EpiResB, true>(lds, g, S, E);
        }
        GSYNC();
        if (PHMASK & (1u << 9)) { PHASE_BEGIN
#pragma unroll 1
            for (int step = 0; step < 2; ++step) {
                if ((step == 0) != ((bid & 1) != 0)) {
                    pg8::Gemm g{X1B, WUP, CH, UPW, DM}; pg8::StaticOrder S; S.init(CH, UPW, G, bid);
                    Epi4 E{UP, PART1};
                    REPS(9) pg8::gemm_phase<Epi4, true>(lds, g, S, E);
                } else if (chunk + 1 < NCHUNK) { BODY_PA(chunk + 1); }
            }
        }
        GSYNC();
        if (PHMASK & (1u << 10)) { PHASE_BEGIN
            const float* cw = PIN(26); const float* cb = PIN(27);
            const int nitems = (CH / 16) * 704;
            REPS(10) for (int it = bid * 512 + tid; it < nitems; it += G * 512) {
                const int cgp = it % 704, rb = it / 704; const int c0 = cgp * 8, r0 = rb * 16; const int pos0 = r0 & (L - 1);
                float wg[3][8], wv[3][8], bg[8], bv[8];
#pragma unroll
                for (int j = 0; j < 3; ++j) {
                    const f32x4 a0 = *(const f32x4*)(cw + j * UPW + c0), a1 = *(const f32x4*)(cw + j * UPW + c0 + 4), b0 = *(const f32x4*)(cw + j * UPW + DFF + c0), b1 = *(const f32x4*)(cw + j * UPW + DFF + c0 + 4);
#pragma unroll
                    for (int e = 0; e < 4; ++e) { wg[j][e] = a0[e]; wg[j][4 + e] = a1[e]; wv[j][e] = b0[e]; wv[j][4 + e] = b1[e]; }
                }
                { const f32x4 a0 = *(const f32x4*)(cb + c0), a1 = *(const f32x4*)(cb + c0 + 4), b0 = *(const f32x4*)(cb + DFF + c0), b1 = *(const f32x4*)(cb + DFF + c0 + 4);
#pragma unroll
                  for (int e = 0; e < 4; ++e) { bg[e] = a0[e]; bg[4 + e] = a1[e]; bv[e] = b0[e]; bv[4 + e] = b1[e]; } }
                const bf16_t* up = UP + (size_t)r0 * UPW + c0;
                const u32x4 z4 = zero4();
                u32x4 pg = (pos0 > 0) ? *(const u32x4*)(up - UPW) : z4, pv = (pos0 > 0) ? *(const u32x4*)(up - UPW + DFF) : z4;
                u32x4 cg_ = *(const u32x4*)up, cv = *(const u32x4*)(up + DFF);
#pragma unroll 4
                for (int rr = 0; rr < 16; ++rr) {
                    const bool hn = (pos0 + rr) < L - 1;
                    const u32x4 ng = hn ? __builtin_nontemporal_load((const u32x4*)(up + (size_t)(rr + 1) * UPW)) : z4, nv = hn ? __builtin_nontemporal_load((const u32x4*)(up + (size_t)(rr + 1) * UPW + DFF)) : z4;
                    float o[8];
#define ACT1(e, PW, CW, NW, PV_, CV_, NV_, SEL) { const float g = wg[0][e] * SEL(PW) + wg[1][e] * SEL(CW) + wg[2][e] * SEL(NW) + bg[e]; const float v = wv[0][e] * SEL(PV_) + wv[1][e] * SEL(CV_) + wv[2][e] * SEL(NV_) + bv[e]; o[e] = g / (1.0f + __expf(-g)) * v; }
                    ACT1(0, pg.x, cg_.x, ng.x, pv.x, cv.x, nv.x, bflo) ACT1(1, pg.x, cg_.x, ng.x, pv.x, cv.x, nv.x, bfhi)
                    ACT1(2, pg.y, cg_.y, ng.y, pv.y, cv.y, nv.y, bflo) ACT1(3, pg.y, cg_.y, ng.y, pv.y, cv.y, nv.y, bfhi)
                    ACT1(4, pg.z, cg_.z, ng.z, pv.z, cv.z, nv.z, bflo) ACT1(5, pg.z, cg_.z, ng.z, pv.z, cv.z, nv.z, bfhi)
                    ACT1(6, pg.w, cg_.w, ng.w, pv.w, cv.w, nv.w, bflo) ACT1(7, pg.w, cg_.w, ng.w, pv.w, cv.w, nv.w, bfhi)
#undef ACT1
                    u32x4 w; w.x = cvt_pk_bf16(o[0], o[1]); w.y = cvt_pk_bf16(o[2], o[3]); w.z = cvt_pk_bf16(o[4], o[5]); w.w = cvt_pk_bf16(o[6], o[7]);
                    *(u32x4*)(ACT + (size_t)(r0 + rr) * DFF + c0) = w;
                    pg = cg_; pv = cv; cg_ = ng; cv = nv;
                }
            }
        }
        GSYNC();
        if (PHMASK & (1u << 11)) { PHASE_BEGIN
            pg8::Gemm g{ACT, WDN, CH, DM, DFF}; pg8::StaticOrder S; S.init(CH, DM, G, bid);
            EpiResB E{X1B, X2B, PART2};
            pg8::gemm_phase<EpiResB, true>(lds, g, S, E);
        }
    }
    GSYNC();
    if (PHMASK & (1u << 12)) { PHASE_BEGIN BODY_FINAL(NCHUNK - 1); }
}

extern "C" void kernel_launch(void* const* d_in, const int* in_sizes, int n_in, void* d_out, int out_size, void* d_ws, size_t ws_size, hipStream_t stream) {
    static int grid = 0;
    if (grid == 0) {
        if (n_in != 30 || ws_size < WS_END) { fprintf(stderr, "kernel_launch: unexpected n_in %d or ws_size %zu\n", n_in, ws_size); grid = -1; return; }
        int dev = 0, cus = 0, per_cu = 0;
        (void)hipGetDevice(&dev);
        (void)hipDeviceGetAttribute(&cus, hipDeviceAttributeMultiprocessorCount, dev);
        (void)hipFuncSetAttribute((const void*)mega_fwd, hipFuncAttributeMaxDynamicSharedMemorySize, LDS_BYTES);
        (void)hipOccupancyMaxActiveBlocksPerMultiprocessor(&per_cu, (const void*)mega_fwd, 512, LDS_BYTES);
        (void)hipGetLastError();
        if (per_cu < 1) per_cu = 1;
        grid = cus;
        fprintf(stderr, "kernel_launch: cus %d per_cu %d grid %d\n", cus, per_cu, grid);
    }
    if (grid < 0) return;
    if (hipMemsetAsync((char*)d_ws + WS_CTL, 0, CTL_BYTES, stream) != hipSuccess) { fprintf(stderr, "kernel_launch: memset failed\n"); return; }
    Params p{};
    for (int i = 0; i < 30; ++i) p.in[i] = (const float*)d_in[i];
    p.out = (float*)d_out; p.ws = (unsigned char*)d_ws;
    void* args[] = {&p};
    hipError_t e = hipLaunchCooperativeKernel((const void*)mega_fwd, dim3(grid), dim3(512), args, LDS_BYTES, stream);
    if (e != hipSuccess) fprintf(stderr, "cooperative launch failed: %s (grid %d)\n", hipGetErrorString(e), grid);
}
```

```cpp
#include <hip/hip_runtime.h>
#include <hip/hip_cooperative_groups.h>
#include <cstdio>
#include <cstdint>
namespace cg = cooperative_groups;

#define LAS __attribute__((address_space(3)))
typedef unsigned short bf16_t;
typedef short bf16x8 __attribute__((ext_vector_type(8)));
typedef short s16x4 __attribute__((ext_vector_type(4)));
typedef float f32x2 __attribute__((ext_vector_type(2)));
typedef float f32x4 __attribute__((ext_vector_type(4)));
typedef float f32x16 __attribute__((ext_vector_type(16)));
typedef unsigned u32x2 __attribute__((ext_vector_type(2)));
typedef unsigned u32x4 __attribute__((ext_vector_type(4)));

constexpr int DM = 2048, CH = 16384, NCHUNK = 3;
constexpr int INW = 10240, DFF = 5632, UPW = 11264;
constexpr float EPS = 1e-6f;
constexpr float QSCALE = 0.125f * 1.4426950408889634f;
constexpr float LAMBDA_INIT = 0.2f;

constexpr size_t MiB = 1u << 20;
constexpr size_t WS_PART1 = 0, WS_PART2 = 2 * MiB, WS_RSTD1 = 4 * MiB, WS_ROPE = 5 * MiB, WS_H3 = 7 * MiB;
constexpr size_t WS_WIN = 10 * MiB, WS_WUP = 50 * MiB, WS_WDN = 94 * MiB, WS_WOUT = 116 * MiB, WS_WA = 124 * MiB, WS_WH = 128 * MiB;
constexpr size_t WS_F4 = 132 * MiB, WS_F8 = 164 * MiB;
constexpr size_t WS_R23 = 228 * MiB;
constexpr size_t WS_R1 = 404 * MiB;
constexpr size_t WS_XB = 916 * MiB;
constexpr size_t WS_CTL = 980 * MiB, CTL_BYTES = 16384;
constexpr size_t WS_END = 981 * MiB;
constexpr size_t R1_QB = 0, R1_KB = 32 * MiB, R1_VB = 64 * MiB, R1_HY = 96 * MiB, R1_GT = 192 * MiB, R1_AT = 320 * MiB, R1_HN = 352 * MiB, R1_UT = 384 * MiB, R1_YT = 416 * MiB, R1_XT = 448 * MiB;

struct Params { const float* in[30]; float* out; unsigned char* ws; };

__device__ __forceinline__ float bflo(unsigned w) { return __uint_as_float(w << 16); }
__device__ __forceinline__ float bfhi(unsigned w) { return __uint_as_float(w & 0xffff0000u); }
__device__ __forceinline__ float bf2f(unsigned short h) { return __uint_as_float((unsigned)h << 16); }
__device__ __forceinline__ unsigned f2bf(float f) { unsigned u = __float_as_uint(f); return (u + 0x7fffu + ((u >> 16) & 1u)) >> 16; }
__device__ __forceinline__ unsigned pk2(float lo, float hi) { return f2bf(lo) | (f2bf(hi) << 16); }
typedef __bf16 bf16x2_t __attribute__((ext_vector_type(2)));
__device__ __forceinline__ unsigned cvt_pk_bf16(float lo, float hi) { f32x2 v = {lo, hi}; bf16x2_t b = __builtin_convertvector(v, bf16x2_t); return __builtin_bit_cast(unsigned, b); }
__device__ __forceinline__ float lane_xor_get(float v, int lane, int o) { return __int_as_float(__builtin_amdgcn_ds_bpermute((lane ^ o) << 2, __float_as_int(v))); }
__device__ __forceinline__ float wave_sum(float v, int lane) {
#pragma unroll
    for (int o = 1; o < 64; o <<= 1) v += lane_xor_get(v, lane, o);
    return v;
}
__device__ __forceinline__ float swap_add(float v) { auto rr = __builtin_amdgcn_permlane32_swap(__float_as_uint(v), __float_as_uint(v), false, false); return __uint_as_float(rr[0]) + __uint_as_float(rr[1]); }
__device__ __forceinline__ float swap_max(float v) { auto rr = __builtin_amdgcn_permlane32_swap(__float_as_uint(v), __float_as_uint(v), false, false); return fmaxf(__uint_as_float(rr[0]), __uint_as_float(rr[1])); }
__device__ __forceinline__ u32x4 zero4() { unsigned z = 0u; asm volatile("" : "+v"(z)); return (u32x4){z, z, z, z}; }
__device__ __forceinline__ void sincos_d(double x, double& s, double& c) {
    const double k = rint(x * 0.63661977236758134308);
    double r = fma(-k, 1.57079632679489655800e+00, x);
    r = fma(-k, 6.12323399573676603587e-17, r);
    const double r2 = r * r;
    const double sp = r * (1.0 + r2 * (-1.0 / 6.0 + r2 * (1.0 / 120.0 + r2 * (-1.0 / 5040.0 + r2 * (1.0 / 362880.0 + r2 * (-1.0 / 39916800.0 + r2 * (1.0 / 6227020800.0)))))));
    const double cp = 1.0 + r2 * (-0.5 + r2 * (1.0 / 24.0 + r2 * (-1.0 / 720.0 + r2 * (1.0 / 40320.0 + r2 * (-1.0 / 3628800.0 + r2 * (1.0 / 479001600.0 + r2 * (-1.0 / 87178291200.0)))))));
    const int q = ((int)k) & 3;
    const double ss = (q & 1) ? cp : sp, cc = (q & 1) ? sp : cp;
    s = (q & 2) ? -ss : ss;
    c = ((q + 1) & 2) ? -cc : cc;
}
__device__ __forceinline__ float sin_f(float x) { double s, c; sincos_d((double)x, s, c); return (float)s; }

namespace pg8 {
constexpr int BM = 256, BK = 64, HALF = 128, HTB = HALF * BK * 2, STAGE_BYTES = 8 * HTB, NXCD = 8, WGM = 8;
__host__ __device__ __forceinline__ int lds_byte(int r, int c) { const int st = (r >> 4) * 2 + (c >> 5), rr = r & 15, cc = c & 31, ob = rr * 64 + cc * 2; return st * 1024 + (ob ^ (((ob >> 9) & 1) << 5)); }
__host__ __device__ __forceinline__ void stage_rc(int b, int& R, int& C) { const int st = b / 1024, sb = b % 1024, swz = sb ^ (((sb >> 9) & 1) << 5); R = (st >> 1) * 16 + swz / 64; C = (st & 1) * 32 + (swz % 64) / 2; }
__host__ __device__ __forceinline__ int perm32(int rho) { const int n = rho >> 4, i = rho & 15; return 8 * (i >> 2) + 4 * n + (i & 3); }
struct Unit { int pm, pn; };
struct Gemm { const bf16_t* A; const bf16_t* Bt; int M, N, K; };
struct StaticOrder {
    int nM, nN, nwg, G, c;
    __device__ void init(int M, int N, int G_, int c_) { nM = M / BM; nN = N / BM; nwg = nM * nN; G = G_; c = c_; }
    __device__ bool next(int i, Unit& u) const {
        const long L = (long)i * G + c; if (L >= nwg) return false;
        int wgid = (int)L; { const int q = nwg / NXCD, r = nwg % NXCD, xcd = wgid % NXCD, off = wgid / NXCD; wgid = (xcd < r ? xcd * (q + 1) : r * (q + 1) + (xcd - r) * q) + off; }
        const int nig = WGM * nN, gid = wgid / nig, fm = gid * WGM, gsz = (nM - fm) < WGM ? (nM - fm) : WGM;
        u.pm = fm + ((wgid % nig) % gsz); u.pn = (wgid % nig) / gsz; return true;
    }
};
template <class Epi, bool ALIGN_EPI>
__device__ __forceinline__ void gemm_phase(LAS unsigned char* lds, const Gemm g, const StaticOrder& S, const Epi& E) {
    int tid = threadIdx.x; asm volatile("" : "+v"(tid));
    const int wid = __builtin_amdgcn_readfirstlane(tid >> 6), lane = tid & 63, wr = wid >> 2, wc = wid & 3, fr = lane & 15, fq = lane >> 4;
    const int K = g.K, nt = K / BK;
    unsigned voffA[2], voffB[2];
#pragma unroll
    for (int i = 0; i < 2; ++i) { int R, C; stage_rc(tid * 16 + i * 8192, R, C); const int Rb = Epi::PERM ? ((R & ~31) + perm32(R & 31)) : R;
        voffA[i] = (unsigned)(R * K + C) * 2u; voffB[i] = (unsigned)(Rb * K + C) * 2u; }
    const size_t kstep = (size_t)(BK * 2);
    const size_t hstep = (size_t)HALF * K * 2;
    const size_t tstep = 2 * hstep;
    const unsigned ldsw = (unsigned)wid * 1024u;
    const int aoff = lds_byte(wr * 64 + fr, fq * 8), boff = lds_byte(wc * 32 + fr, fq * 8);
#define PG8_SA(b, h) (((b) * 2 + (h)) * HTB)
#define PG8_SB(b, h) ((4 + (b) * 2 + (h)) * HTB)
#define PG8_STAGE(bufoff, gbase, voff) do { _Pragma("unroll") for (int _i = 0; _i < 2; ++_i) \
        __builtin_amdgcn_global_load_lds((const unsigned*)((const char*)(gbase) + (voff)[_i]), (LAS unsigned*)(lds + (bufoff) + ldsw + _i * 8192), 16, 0, 0); } while (0)
#define PG8_LDA(dst, b, h) do { _Pragma("unroll") for (int m = 0; m < 4; ++m) _Pragma("unroll") for (int k = 0; k < 2; ++k) dst[m][k] = *(const LAS bf16x8*)(lds + PG8_SA(b, h) + aoff + m * 2048 + k * 1024); } while (0)
#define PG8_LDB(dst, b, h) do { _Pragma("unroll") for (int n = 0; n < 2; ++n) _Pragma("unroll") for (int k = 0; k < 2; ++k) dst[n][k] = *(const LAS bf16x8*)(lds + PG8_SB(b, h) + boff + n * 2048 + k * 1024); } while (0)
#define PG8_MMA(ai, bj, At, Bt) do { __builtin_amdgcn_s_setprio(1); _Pragma("unroll") for (int m = 0; m < 4; ++m) _Pragma("unroll") for (int n = 0; n < 2; ++n) _Pragma("unroll") for (int k = 0; k < 2; ++k) \
        acc[ai][bj][m][n] = __builtin_amdgcn_mfma_f32_16x16x32_bf16(Bt[n][k], At[m][k], acc[ai][bj][m][n], 0, 0, 0); __builtin_amdgcn_s_setprio(0); } while (0)
#define PG8_WAIT_V(n) asm volatile("s_waitcnt vmcnt(" #n ")" ::: "memory")
#define PG8_WAIT_L(n) asm volatile("s_waitcnt lgkmcnt(" #n ")" ::: "memory")
#define PG8_BAR __builtin_amdgcn_s_barrier()
#define PG8_SCHED __builtin_amdgcn_sched_barrier(0)
    Unit cur, nxt; int ui = 0;
    if (!S.next(0, cur)) return;
    f32x4 acc[2][2][4][2];
#pragma unroll
    for (int a = 0; a < 2; ++a)
#pragma unroll
        for (int b = 0; b < 2; ++b)
#pragma unroll
            for (int m = 0; m < 4; ++m)
#pragma unroll
                for (int n = 0; n < 2; ++n) acc[a][b][m][n] = (f32x4){0.f, 0.f, 0.f, 0.f};
    bf16x8 At[4][2], B0[2][2], B1[2][2];
    const char* cA = (const char*)g.A + (size_t)cur.pm * tstep; const char* cB = (const char*)g.Bt + (size_t)cur.pn * tstep;
    PG8_STAGE(PG8_SB(0, 0), cB, voffB); PG8_STAGE(PG8_SB(0, 1), cB + hstep, voffB); PG8_STAGE(PG8_SA(0, 0), cA, voffA); PG8_STAGE(PG8_SA(0, 1), cA + hstep, voffA);
    if (wr == 1) PG8_BAR;
    PG8_WAIT_V(2); PG8_BAR;
    PG8_STAGE(PG8_SB(1, 0), cB + kstep, voffB); PG8_STAGE(PG8_SA(1, 0), cA + kstep, voffA); PG8_STAGE(PG8_SB(1, 1), cB + hstep + kstep, voffB);
    PG8_WAIT_V(6); PG8_BAR;
    for (;;) {
        const bool has_next = S.next(ui + 1, nxt);
        const char* nA = has_next ? (const char*)g.A + (size_t)nxt.pm * tstep : cA; const char* nB = has_next ? (const char*)g.Bt + (size_t)nxt.pn * tstep : cB;
        for (int t = 0; t < nt; t += 2) {
            const bool last = (t == nt - 2);
            const char* a1 = cA + (size_t)(t + 1) * kstep;
            const char* a2 = last ? nA : cA + (size_t)(t + 2) * kstep; const char* b2 = last ? nB : cB + (size_t)(t + 2) * kstep;
            const char* a3 = a2 + kstep; const char* b3 = b2 + kstep;
            PG8_LDB(B0, 0, 0); PG8_LDB(B1, 0, 1); PG8_SCHED; PG8_LDA(At, 0, 0); PG8_STAGE(PG8_SA(1, 1), a1 + hstep, voffA);
            PG8_WAIT_V(8); PG8_WAIT_L(0); PG8_BAR; PG8_MMA(0, 0, At, B0); PG8_MMA(0, 1, At, B1); PG8_BAR; PG8_SCHED;
            PG8_LDA(At, 0, 1); PG8_STAGE(PG8_SB(0, 0), b2, voffB); PG8_STAGE(PG8_SB(0, 1), b2 + hstep, voffB); PG8_STAGE(PG8_SA(0, 0), a2, voffA);
            PG8_WAIT_V(8); PG8_WAIT_L(0); PG8_BAR; PG8_MMA(1, 0, At, B0); PG8_MMA(1, 1, At, B1); PG8_BAR; PG8_SCHED;
            PG8_LDB(B0, 1, 0); PG8_LDB(B1, 1, 1); PG8_SCHED; PG8_LDA(At, 1, 0); PG8_STAGE(PG8_SA(0, 1), a2 + hstep, voffA);
            PG8_WAIT_V(8); PG8_WAIT_L(0); PG8_BAR; PG8_MMA(0, 0, At, B0); PG8_MMA(0, 1, At, B1); PG8_BAR; PG8_SCHED;
            PG8_LDA(At, 1, 1); PG8_STAGE(PG8_SB(1, 0), b3, voffB); PG8_STAGE(PG8_SB(1, 1), b3 + hstep, voffB); PG8_STAGE(PG8_SA(1, 0), a3, voffA);
            PG8_WAIT_V(8); PG8_WAIT_L(0); PG8_BAR; PG8_MMA(1, 0, At, B0); PG8_MMA(1, 1, At, B1); PG8_BAR; PG8_SCHED;
            if constexpr (Epi::MIDK) { if (t + 2 == (nt >> 1)) E.mid(acc, cur, wr, wc, fr, fq); }
        }
        if constexpr (ALIGN_EPI) { if (wr == 0) PG8_BAR; }
        E(acc, cur, wr, wc, fr, fq);
        if (!has_next) break;
#pragma unroll
        for (int a = 0; a < 2; ++a)
#pragma unroll
            for (int b = 0; b < 2; ++b)
#pragma unroll
                for (int m = 0; m < 4; ++m)
#pragma unroll
                    for (int n = 0; n < 2; ++n) acc[a][b][m][n] = (f32x4){0.f, 0.f, 0.f, 0.f};
        cur = nxt; cA = nA; cB = nB; ++ui;
        if constexpr (ALIGN_EPI) { if (wr == 1) PG8_BAR; }
    }
    PG8_WAIT_V(0);
    if constexpr (!ALIGN_EPI) { if (wr == 0) PG8_BAR; }
    PG8_BAR;
#undef PG8_SA
#undef PG8_SB
#undef PG8_STAGE
#undef PG8_LDA
#undef PG8_LDB
#undef PG8_MMA
#undef PG8_WAIT_V
#undef PG8_WAIT_L
#undef PG8_BAR
#undef PG8_SCHED
}
}

struct Epi1 {
    static constexpr bool PERM = true, MIDK = false;
    bf16_t *QB, *KB, *VB, *HY, *GT, *XTp; const float* rstd; const float* gate_b; const f32x2* rope; int L;
    __device__ __forceinline__ void operator()(const f32x4 (&acc)[2][2][4][2], const pg8::Unit& u, int wr, int wc, int fr, int fq) const {
        const int pn = u.pn; const int row0 = u.pm * 256 + wr * 64 + fr;
#pragma unroll
        for (int ai = 0; ai < 2; ++ai)
#pragma unroll
            for (int m = 0; m < 4; ++m) {
                const int row = row0 + ai * 128 + m * 16; const float rs = rstd[row]; const int pos = row & (L - 1);
#pragma unroll
                for (int bj = 0; bj < 2; ++bj) {
                    const int lc = bj * 128 + wc * 32 + 8 * fq;
                    f32x4 v0 = acc[ai][bj][m][0] * rs, v1 = acc[ai][bj][m][1] * rs;
                    bf16_t* dst;
                    if (pn < 8) {
                        const int col = (pn & 3) * 256 + lc; const int i0 = (col & 63) >> 1;
                        const f32x2* rp = rope + (size_t)pos * 32 + i0;
                        const f32x2 c0 = rp[0], c1 = rp[1], c2 = rp[2], c3 = rp[3];
                        const float sc = (pn < 4) ? QSCALE : 1.0f;
                        f32x4 w0, w1;
                        w0[0] = (v0[0] * c0[0] - v0[1] * c0[1]) * sc; w0[1] = (v0[1] * c0[0] + v0[0] * c0[1]) * sc;
                        w0[2] = (v0[2] * c1[0] - v0[3] * c1[1]) * sc; w0[3] = (v0[3] * c1[0] + v0[2] * c1[1]) * sc;
                        w1[0] = (v1[0] * c2[0] - v1[1] * c2[1]) * sc; w1[1] = (v1[1] * c2[0] + v1[0] * c2[1]) * sc;
                        w1[2] = (v1[2] * c3[0] - v1[3] * c3[1]) * sc; w1[3] = (v1[3] * c3[0] + v1[2] * c3[1]) * sc;
                        v0 = w0; v1 = w1;
                        dst = ((pn < 4) ? QB : KB) + (size_t)row * 1024 + col;
                    } else if (pn < 12) {
                        dst = VB + (size_t)row * 1024 + (pn - 8) * 256 + lc;
                    } else if (pn < 16) {
                        dst = HY + (size_t)row * 3072 + (pn - 12) * 256 + lc;
                    } else if (pn < 24) {
                        bf16_t* xt = XTp + (size_t)((pn - 16) * 256 + lc) * CH + row;
#pragma unroll
                        for (int e = 0; e < 4; ++e) { xt[(size_t)e * CH] = (bf16_t)f2bf(v0[e]); xt[(size_t)(4 + e) * CH] = (bf16_t)f2bf(v1[e]); }
                        continue;
                    } else {
                        const int gc = (pn - 24) * 256 + lc;
                        const f32x4 b0 = *(const f32x4*)(gate_b + gc), b1 = *(const f32x4*)(gate_b + gc + 4);
#pragma unroll
                        for (int e = 0; e < 4; ++e) { v0[e] = __builtin_amdgcn_rcpf(1.0f + __expf(-(v0[e] + b0[e]))); v1[e] = __builtin_amdgcn_rcpf(1.0f + __expf(-(v1[e] + b1[e]))); }
                        dst = GT + (size_t)row * 4096 + gc;
                    }
                    u32x4 w; w.x = cvt_pk_bf16(v0[0], v0[1]); w.y = cvt_pk_bf16(v0[2], v0[3]); w.z = cvt_pk_bf16(v1[0], v1[1]); w.w = cvt_pk_bf16(v1[2], v1[3]);
                    *(u32x4*)dst = w;
                }
            }
    }
};
template <int PASS> struct Epi2 {
    static constexpr bool PERM = true, MIDK = false;
    const bf16_t* GT; bf16_t* T1; bf16_t* MG;
    __device__ __forceinline__ void operator()(const f32x4 (&acc)[2][2][4][2], const pg8::Unit& u, int wr, int wc, int fr, int fq) const {
        const int row0 = u.pm * 256 + wr * 64 + fr;
#pragma unroll
        for (int ai = 0; ai < 2; ++ai)
#pragma unroll
            for (int m = 0; m < 4; ++m) {
                const int row = row0 + ai * 128 + m * 16;
#pragma unroll
                for (int bj = 0; bj < 2; ++bj) {
                    const int col = u.pn * 256 + bj * 128 + wc * 32 + 8 * fq;
                    const u32x4 gw = *(const u32x4*)(GT + (size_t)row * 4096 + PASS * 2048 + col);
                    f32x4 v0 = acc[ai][bj][m][0], v1 = acc[ai][bj][m][1];
                    v0[0] *= bflo(gw.x); v0[1] *= bfhi(gw.x); v0[2] *= bflo(gw.y); v0[3] *= bfhi(gw.y);
                    v1[0] *= bflo(gw.z); v1[1] *= bfhi(gw.z); v1[2] *= bflo(gw.w); v1[3] *= bfhi(gw.w);
                    if (PASS == 1) {
                        const u32x4 tw = *(const u32x4*)(T1 + (size_t)row * 2048 + col);
                        v0[0] += bflo(tw.x); v0[1] += bfhi(tw.x); v0[2] += bflo(tw.y); v0[3] += bfhi(tw.y);
                        v1[0] += bflo(tw.z); v1[1] += bfhi(tw.z); v1[2] += bflo(tw.w); v1[3] += bfhi(tw.w);
                    }
                    u32x4 w; w.x = cvt_pk_bf16(v0[0], v0[1]); w.y = cvt_pk_bf16(v0[2], v0[3]); w.z = cvt_pk_bf16(v1[0], v1[1]); w.w = cvt_pk_bf16(v1[2], v1[3]);
                    *(u32x4*)((PASS == 0 ? T1 : MG) + (size_t)row * 2048 + col) = w;
                }
            }
    }
};
struct Epi2M {
    static constexpr bool PERM = true, MIDK = true;
    const bf16_t* GT; bf16_t* MG;
    __device__ __forceinline__ void mid(f32x4 (&acc)[2][2][4][2], const pg8::Unit& u, int wr, int wc, int fr, int fq) const {
        int row0 = u.pm * 256 + wr * 64 + fr; asm volatile("" : "+v"(row0));
#pragma unroll
        for (int ai = 0; ai < 2; ++ai)
#pragma unroll
            for (int m = 0; m < 4; ++m) {
                const int row = row0 + ai * 128 + m * 16;
#pragma unroll
                for (int bj = 0; bj < 2; ++bj) {
                    const int col = u.pn * 256 + bj * 128 + wc * 32 + 8 * fq;
                    const u32x4 a = *(const u32x4*)(GT + (size_t)row * 4096 + col), b = *(const u32x4*)(GT + (size_t)row * 4096 + 2048 + col);
                    acc[ai][bj][m][0][0] *= bflo(a.x) * __builtin_amdgcn_rcpf(bflo(b.x)); acc[ai][bj][m][0][1] *= bfhi(a.x) * __builtin_amdgcn_rcpf(bfhi(b.x));
                    acc[ai][bj][m][0][2] *= bflo(a.y) * __builtin_amdgcn_rcpf(bflo(b.y)); acc[ai][bj][m][0][3] *= bfhi(a.y) * __builtin_amdgcn_rcpf(bfhi(b.y));
                    acc[ai][bj][m][1][0] *= bflo(a.z) * __builtin_amdgcn_rcpf(bflo(b.z)); acc[ai][bj][m][1][1] *= bfhi(a.z) * __builtin_amdgcn_rcpf(bfhi(b.z));
                    acc[ai][bj][m][1][2] *= bflo(a.w) * __builtin_amdgcn_rcpf(bflo(b.w)); acc[ai][bj][m][1][3] *= bfhi(a.w) * __builtin_amdgcn_rcpf(bfhi(b.w));
                    __builtin_amdgcn_sched_barrier(0);
                }
            }
    }
    __device__ __forceinline__ void operator()(const f32x4 (&acc)[2][2][4][2], const pg8::Unit& u, int wr, int wc, int fr, int fq) const {
        const int row0 = u.pm * 256 + wr * 64 + fr;
#pragma unroll
        for (int ai = 0; ai < 2; ++ai)
#pragma unroll
            for (int m = 0; m < 4; ++m) {
                const int row = row0 + ai * 128 + m * 16;
#pragma unroll
                for (int bj = 0; bj < 2; ++bj) {
                    const int col = u.pn * 256 + bj * 128 + wc * 32 + 8 * fq;
                    const u32x4 gw = *(const u32x4*)(GT + (size_t)row * 4096 + 2048 + col);
                    f32x4 v0 = acc[ai][bj][m][0], v1 = acc[ai][bj][m][1];
                    v0[0] *= bflo(gw.x); v0[1] *= bfhi(gw.x); v0[2] *= bflo(gw.y); v0[3] *= bfhi(gw.y);
                    v1[0] *= bflo(gw.z); v1[1] *= bfhi(gw.z); v1[2] *= bflo(gw.w); v1[3] *= bfhi(gw.w);
                    u32x4 w; w.x = cvt_pk_bf16(v0[0], v0[1]); w.y = cvt_pk_bf16(v0[2], v0[3]); w.z = cvt_pk_bf16(v1[0], v1[1]); w.w = cvt_pk_bf16(v1[2], v1[3]);
                    *(u32x4*)(MG + (size_t)row * 2048 + col) = w;
                }
            }
    }
};
template <bool WB> struct EpiRes {
    static constexpr bool PERM = false, MIDK = false;
    const float* base; float* out; bf16_t* ob; float* part;
    __device__ __forceinline__ void operator()(const f32x4 (&acc)[2][2][4][2], const pg8::Unit& u, int wr, int wc, int fr, int fq) const {
        const int row0 = u.pm * 256 + wr * 64 + fr;
#pragma unroll
        for (int ai = 0; ai < 2; ++ai)
#pragma unroll
            for (int m = 0; m < 4; ++m) {
                const int row = row0 + ai * 128 + m * 16; float ss = 0.f;
#pragma unroll
                for (int bj = 0; bj < 2; ++bj)
#pragma unroll
                    for (int n = 0; n < 2; ++n) {
                        const size_t off = (size_t)row * 2048 + u.pn * 256 + bj * 128 + wc * 32 + n * 16 + 4 * fq;
                        const f32x4 v = *(const f32x4*)(base + off) + acc[ai][bj][m][n];
                        *(f32x4*)(out + off) = v;
                        if (WB) { u32x2 w; w.x = cvt_pk_bf16(v[0], v[1]); w.y = cvt_pk_bf16(v[2], v[3]); *(u32x2*)(ob + off) = w; }
                        ss += (v[0] * v[0] + v[1] * v[1]) + (v[2] * v[2] + v[3] * v[3]);
                    }
                { const int ln = fr + 16 * fq; ss += lane_xor_get(ss, ln, 16); ss += lane_xor_get(ss, ln, 32); }
                if (fq == 0) part[(size_t)row * 32 + u.pn * 4 + wc] = ss;
            }
    }
};
struct EpiResB {
    static constexpr bool PERM = true, MIDK = false;
    const bf16_t* base; bf16_t* ob; float* part;
    __device__ __forceinline__ void operator()(const f32x4 (&acc)[2][2][4][2], const pg8::Unit& u, int wr, int wc, int fr, int fq) const {
        const int row0 = u.pm * 256 + wr * 64 + fr;
#pragma unroll
        for (int ai = 0; ai < 2; ++ai)
#pragma unroll
            for (int m = 0; m < 4; ++m) {
                const int row = row0 + ai * 128 + m * 16; float ss = 0.f;
#pragma unroll
                for (int bj = 0; bj < 2; ++bj) {
                    const size_t off = (size_t)row * 2048 + u.pn * 256 + bj * 128 + wc * 32 + 8 * fq;
                    const u32x4 bw = *(const u32x4*)(base + off);
                    f32x4 v0 = acc[ai][bj][m][0], v1 = acc[ai][bj][m][1];
                    v0[0] += bflo(bw.x); v0[1] += bfhi(bw.x); v0[2] += bflo(bw.y); v0[3] += bfhi(bw.y);
                    v1[0] += bflo(bw.z); v1[1] += bfhi(bw.z); v1[2] += bflo(bw.w); v1[3] += bfhi(bw.w);
                    ss += ((v0[0] * v0[0] + v0[1] * v0[1]) + (v0[2] * v0[2] + v0[3] * v0[3])) + ((v1[0] * v1[0] + v1[1] * v1[1]) + (v1[2] * v1[2] + v1[3] * v1[3]));
                    u32x4 w; w.x = cvt_pk_bf16(v0[0], v0[1]); w.y = cvt_pk_bf16(v0[2], v0[3]); w.z = cvt_pk_bf16(v1[0], v1[1]); w.w = cvt_pk_bf16(v1[2], v1[3]);
                    *(u32x4*)(ob + off) = w;
                }
                { const int ln = fr + 16 * fq; ss += lane_xor_get(ss, ln, 16); ss += lane_xor_get(ss, ln, 32); }
                if (fq == 0) part[(size_t)row * 32 + u.pn * 4 + wc] = ss;
            }
    }
};
struct Epi4 {
    static constexpr bool PERM = true, MIDK = false;
    bf16_t* UP; const float* part;
    __device__ __forceinline__ void operator()(const f32x4 (&acc)[2][2][4][2], const pg8::Unit& u, int wr, int wc, int fr, int fq) const {
        const int row0 = u.pm * 256 + wr * 64 + fr;
#pragma unroll
        for (int ai = 0; ai < 2; ++ai)
#pragma unroll
            for (int m = 0; m < 4; ++m) {
                const int row = row0 + ai * 128 + m * 16;
                const f32x4 pa = *(const f32x4*)(part + (size_t)row * 32 + 8 * fq), pb = *(const f32x4*)(part + (size_t)row * 32 + 8 * fq + 4);
                float s = ((pa[0] + pa[1]) + (pa[2] + pa[3])) + ((pb[0] + pb[1]) + (pb[2] + pb[3]));
                { const int ln = fr + 16 * fq; s += lane_xor_get(s, ln, 16); s += lane_xor_get(s, ln, 32); }
                const float rs = rsqrtf(s * (1.0f / 2048.0f) + EPS);
#pragma unroll
                for (int bj = 0; bj < 2; ++bj) {
                    const int col = u.pn * 256 + bj * 128 + wc * 32 + 8 * fq;
                    const f32x4 v0 = acc[ai][bj][m][0] * rs, v1 = acc[ai][bj][m][1] * rs;
                    u32x4 w; w.x = cvt_pk_bf16(v0[0], v0[1]); w.y = cvt_pk_bf16(v0[2], v0[3]); w.z = cvt_pk_bf16(v1[0], v1[1]); w.w = cvt_pk_bf16(v1[2], v1[3]);
                    *(u32x4*)(UP + (size_t)row * UPW + col) = w;
                }
            }
    }
};

__device__ __forceinline__ void transpose_item(const float* W, int K, int N, bf16_t* WT, const float* g, bool ropeperm, LAS float* scr, int item, int lane, int ldk = 0, int koff = 0) {
    if (ldk == 0) ldk = K;
    const int nblk = N / 64, kb = item / nblk, nb = item % nblk, k0 = 64 * kb, n0 = 64 * nb;
    int sn = n0 + lane;
    if (ropeperm && sn < 2048) sn = (sn & ~63) + ((sn & 63) >> 1) + 32 * (sn & 1);
    float wv[64];
#pragma unroll
    for (int kk = 0; kk < 64; ++kk) wv[kk] = __builtin_nontemporal_load(W + (size_t)(k0 + kk) * N + sn);
    if (g) {
#pragma unroll
        for (int kk = 0; kk < 64; kk += 4) { const f32x4 gg = *(const f32x4*)(g + k0 + kk); wv[kk] *= gg[0]; wv[kk + 1] *= gg[1]; wv[kk + 2] *= gg[2]; wv[kk + 3] *= gg[3]; }
    }
#pragma unroll
    for (int kk = 0; kk < 64; ++kk) scr[kk * 65 + lane] = wv[kk];
    asm volatile("s_waitcnt lgkmcnt(0)" ::: "memory");
    const int c = lane & 7;
#pragma unroll
    for (int j = 0; j < 8; ++j) { const int n = (lane >> 3) + 8 * j; const LAS float* s = scr + (8 * c) * 65 + n;
        u32x4 o; o.x = pk2(s[0 * 65], s[1 * 65]); o.y = pk2(s[2 * 65], s[3 * 65]); o.z = pk2(s[4 * 65], s[5 * 65]); o.w = pk2(s[6 * 65], s[7 * 65]);
        *(u32x4*)(WT + (size_t)(n0 + n) * ldk + koff + k0 + 8 * c) = o; }
    asm volatile("s_waitcnt lgkmcnt(0)" ::: "memory");
}

constexpr int AT_KB = 64 * 272, AT_VB = 64 * 320, AT_BUF = AT_KB + AT_VB;
__device__ __forceinline__ void attn_stage(LAS unsigned char* lds, int bufoff, const bf16_t* Kg, const bf16_t* Vg, int wid, int lane) {
#pragma unroll
    for (int i = 0; i < 5; ++i) {
        const int pc = wid + 8 * i;
        if (pc < 37) {
            const bool isk = pc < 17; const int o = (isk ? pc : pc - 17) * 1024 + lane * 16;
            const int pitch = isk ? 272 : 320; const int row = o / pitch; int ch = (o - row * pitch) >> 4; if (ch > 15) ch = 0;
            const bf16_t* src = (isk ? Kg : Vg) + (unsigned)(row * 1024 + ch * 8);
            __builtin_amdgcn_global_load_lds((const unsigned*)src, (LAS unsigned*)(lds + bufoff + (isk ? 0 : AT_KB) + (isk ? pc : pc - 17) * 1024), 16, 0, 0);
        }
    }
}
__device__ __forceinline__ s16x4 vtr(const LAS unsigned char* p) { typedef short v4i16_t __attribute__((ext_vector_type(4))); return __builtin_bit_cast(s16x4, __builtin_amdgcn_ds_read_tr16_b64_v4i16((LAS v4i16_t*)p)); }

__device__ __forceinline__ void softmax_step(f32x16& s, float& m, float& l, f32x16 (&o)[4], bf16x8 (&pk)[2]) {
    float a = fmaxf(fmaxf(s[0], s[1]), s[2]), b = fmaxf(fmaxf(s[3], s[4]), s[5]);
    a = fmaxf(fmaxf(a, s[6]), s[7]); b = fmaxf(fmaxf(b, s[8]), s[9]);
    a = fmaxf(fmaxf(a, s[10]), s[11]); b = fmaxf(fmaxf(b, s[12]), s[13]);
    a = fmaxf(fmaxf(a, s[14]), s[15]);
    const float mx = swap_max(fmaxf(a, b));
    if (__any(mx > m + 8.0f)) {
        const float mn = fmaxf(m, mx);
        const float alpha = __builtin_amdgcn_exp2f(m - mn);
#pragma unroll
        for (int d = 0; d < 4; ++d)
#pragma unroll
            for (int r = 0; r < 16; ++r) o[d][r] *= alpha;
        l *= alpha; m = mn;
    }
    float sum = 0.f;
#pragma unroll
    for (int r = 0; r < 16; ++r) { s[r] = __builtin_amdgcn_exp2f(s[r] - m); sum += s[r]; }
    l += sum;
#pragma unroll
    for (int ks = 0; ks < 2; ++ks) {
        u32x4 w; w.x = cvt_pk_bf16(s[8 * ks + 0], s[8 * ks + 1]); w.y = cvt_pk_bf16(s[8 * ks + 2], s[8 * ks + 3]); w.z = cvt_pk_bf16(s[8 * ks + 4], s[8 * ks + 5]); w.w = cvt_pk_bf16(s[8 * ks + 6], s[8 * ks + 7]);
        pk[ks] = __builtin_bit_cast(bf16x8, w);
    }
}

__device__ __forceinline__ void softmax_step64(f32x16& sa, f32x16& sb, float& m, float& l, f32x16 (&o)[4], bf16x8 (&pk)[4]) {
    float a = fmaxf(fmaxf(sa[0], sa[1]), sa[2]), b = fmaxf(fmaxf(sb[0], sb[1]), sb[2]);
#pragma unroll
    for (int r = 3; r < 15; r += 2) { a = fmaxf(fmaxf(a, sa[r]), sa[r + 1]); b = fmaxf(fmaxf(b, sb[r]), sb[r + 1]); }
    a = fmaxf(a, sa[15]); b = fmaxf(b, sb[15]);
    const float mx = swap_max(fmaxf(a, b));
    if (__any(mx > m + 8.0f)) {
        const float mn = fmaxf(m, mx);
        const float alpha = __builtin_amdgcn_exp2f(m - mn);
#pragma unroll
        for (int d = 0; d < 4; ++d)
#pragma unroll
            for (int r = 0; r < 16; ++r) o[d][r] *= alpha;
        l *= alpha; m = mn;
    }
    float sum = 0.f;
#pragma unroll
    for (int r = 0; r < 16; ++r) { sa[r] = __builtin_amdgcn_exp2f(sa[r] - m); sb[r] = __builtin_amdgcn_exp2f(sb[r] - m); sum += sa[r] + sb[r]; }
    l += sum;
#pragma unroll
    for (int ks = 0; ks < 2; ++ks) {
        u32x4 w; w.x = cvt_pk_bf16(sa[8 * ks + 0], sa[8 * ks + 1]); w.y = cvt_pk_bf16(sa[8 * ks + 2], sa[8 * ks + 3]); w.z = cvt_pk_bf16(sa[8 * ks + 4], sa[8 * ks + 5]); w.w = cvt_pk_bf16(sa[8 * ks + 6], sa[8 * ks + 7]);
        pk[ks] = __builtin_bit_cast(bf16x8, w);
        u32x4 v; v.x = cvt_pk_bf16(sb[8 * ks + 0], sb[8 * ks + 1]); v.y = cvt_pk_bf16(sb[8 * ks + 2], sb[8 * ks + 3]); v.z = cvt_pk_bf16(sb[8 * ks + 4], sb[8 * ks + 5]); v.w = cvt_pk_bf16(sb[8 * ks + 6], sb[8 * ks + 7]);
        pk[2 + ks] = __builtin_bit_cast(bf16x8, v);
    }
}
__device__ __forceinline__ void attn_item(LAS unsigned char* lds, const bf16_t* QB, const bf16_t* KB, const bf16_t* VB, bf16_t* AT, int tb, int h, int qb, int L, float lam, const float* subln) {
    int tid = threadIdx.x; asm volatile("" : "+v"(tid));
    const int lane = tid & 63, r32 = lane & 31, hi = lane >> 5; const int wid = __builtin_amdgcn_readfirstlane(tid >> 6);
    const int tokq = tb + qb * 256 + wid * 32 + r32;
    LAS unsigned char* qs = lds + 2 * AT_BUF + wid * 8704 + r32 * 272 + hi * 16;
#pragma unroll
    for (int mp = 0; mp < 2; ++mp)
#pragma unroll
        for (int d0 = 0; d0 < 4; ++d0) *(LAS bf16x8*)(qs + mp * 128 + d0 * 32) = *(const bf16x8*)(QB + (size_t)tokq * 1024 + h * 128 + mp * 64 + d0 * 16 + hi * 8);
    f32x16 o0[4], o1[4];
#pragma unroll
    for (int d = 0; d < 4; ++d)
#pragma unroll
        for (int r = 0; r < 16; ++r) { o0[d][r] = 0.f; o1[d][r] = 0.f; }
    float m0 = -INFINITY, m1 = -INFINITY, l0 = 0.f, l1 = 0.f;
    const bf16_t* Kh = KB + (size_t)tb * 1024 + h * 128; const bf16_t* Vh = VB + (size_t)tb * 1024 + h * 128;
    const int NT = L / 64;
    const int qd = (lane & 15) >> 2, pp = lane & 3, blk = (lane >> 4) & 1;
    const int koff = r32 * 272 + hi * 16;
    const int voff = AT_KB + (4 * hi + qd) * 320 + (16 * blk + 4 * pp) * 2;
    bf16x8 pk0[4], pk1[4];
#define AT_S64(cbuf, MP, MM, LL, OO, PK) do { \
        const LAS unsigned char* kp = lds + (cbuf) + koff + (MP) * 128; \
        bf16x8 qa[4], ka[4], kb[4]; \
        f32x16 sa, sb; _Pragma("unroll") for (int r = 0; r < 16; ++r) { sa[r] = 0.f; sb[r] = 0.f; } \
        _Pragma("unroll") for (int d0 = 0; d0 < 2; ++d0) { qa[d0] = *(const LAS bf16x8*)(qs + (MP) * 128 + d0 * 32); ka[d0] = *(const LAS bf16x8*)(kp + d0 * 32); kb[d0] = *(const LAS bf16x8*)(kp + 32 * 272 + d0 * 32); } \
        __builtin_amdgcn_sched_barrier(0); \
        _Pragma("unroll") for (int d0 = 0; d0 < 2; ++d0) { \
            sa = __builtin_amdgcn_mfma_f32_32x32x16_bf16(ka[d0], qa[d0], sa, 0, 0, 0); \
            sb = __builtin_amdgcn_mfma_f32_32x32x16_bf16(kb[d0], qa[d0], sb, 0, 0, 0); } \
        _Pragma("unroll") for (int d0 = 2; d0 < 4; ++d0) { qa[d0] = *(const LAS bf16x8*)(qs + (MP) * 128 + d0 * 32); ka[d0] = *(const LAS bf16x8*)(kp + d0 * 32); kb[d0] = *(const LAS bf16x8*)(kp + 32 * 272 + d0 * 32); } \
        __builtin_amdgcn_sched_barrier(0); \
        _Pragma("unroll") for (int d0 = 2; d0 < 4; ++d0) { \
            sa = __builtin_amdgcn_mfma_f32_32x32x16_bf16(ka[d0], qa[d0], sa, 0, 0, 0); \
            sb = __builtin_amdgcn_mfma_f32_32x32x16_bf16(kb[d0], qa[d0], sb, 0, 0, 0); } \
        __builtin_amdgcn_sched_barrier(0); \
        softmax_step64(sa, sb, MM, LL, OO, PK); \
        __builtin_amdgcn_sched_barrier(0); } while (0)
#define AT_PV64(cbuf, sub) do { \
        const LAS unsigned char* vp = lds + (cbuf) + voff + (sub) * 32 * 320; \
        _Pragma("unroll") for (int hh = 0; hh < 2; ++hh) { \
            s16x4 vlo[4], vhi[4]; \
            _Pragma("unroll") for (int i2 = 0; i2 < 4; ++i2) { const int i = 4 * hh + i2; vlo[i2] = vtr(vp + (i & 1) * 16 * 320 + (i >> 1) * 64); vhi[i2] = vtr(vp + (i & 1) * 16 * 320 + 8 * 320 + (i >> 1) * 64); } \
            __builtin_amdgcn_sched_barrier(0); \
            _Pragma("unroll") for (int i2 = 0; i2 < 4; ++i2) { const int i = 4 * hh + i2; \
                const bf16x8 vf = (bf16x8){vlo[i2][0], vlo[i2][1], vlo[i2][2], vlo[i2][3], vhi[i2][0], vhi[i2][1], vhi[i2][2], vhi[i2][3]}; \
                o0[i >> 1] = __builtin_amdgcn_mfma_f32_32x32x16_bf16(vf, pk0[2 * (sub) + (i & 1)], o0[i >> 1], 0, 0, 0); \
                o1[i >> 1] = __builtin_amdgcn_mfma_f32_32x32x16_bf16(vf, pk1[2 * (sub) + (i & 1)], o1[i >> 1], 0, 0, 0); } \
            __builtin_amdgcn_sched_barrier(0); } } while (0)
    attn_stage(lds, 0, Kh, Vh, wid, lane);
    asm volatile("s_waitcnt vmcnt(0)" ::: "memory"); __syncthreads();
    for (int t = 0; t < NT; ++t) {
        const int cb = (t & 1) * AT_BUF;
        if (t + 1 < NT) attn_stage(lds, AT_BUF - cb, Kh + (size_t)(t + 1) * 64 * 1024, Vh + (size_t)(t + 1) * 64 * 1024, wid, lane);
        AT_S64(cb, 0, m0, l0, o0, pk0);
        AT_S64(cb, 1, m1, l1, o1, pk1);
        AT_PV64(cb, 0);
        AT_PV64(cb, 1);
        asm volatile("s_waitcnt vmcnt(0)" ::: "memory"); __syncthreads();
    }
#undef AT_S64
#undef AT_PV64
    int tq2 = tb + qb * 256 + wid * 32 + r32; asm volatile("" : "+v"(tq2));
    l0 = swap_add(l0); l1 = swap_add(l1);
    const float i0 = 1.0f / l0, i1 = __uint_as_float((unsigned)__builtin_amdgcn_readfirstlane((int)__float_as_uint(lam))) / l1;
    float ss = 0.f;
#pragma unroll
    for (int d = 0; d < 4; ++d)
#pragma unroll
        for (int r = 0; r < 16; ++r) { const float a = o0[d][r] * i0 - o1[d][r] * i1; o0[d][r] = a; ss += a * a; }
    ss = swap_add(ss);
    const float rs = rsqrtf(ss * (1.0f / 128.0f) + EPS) * (1.0f - LAMBDA_INIT);
    bf16_t* orow = AT + (size_t)tq2 * 2048 + h * 128;
#pragma unroll
    for (int d = 0; d < 4; ++d)
#pragma unroll
        for (int g = 0; g < 4; ++g) {
            const int dd = 32 * d + 8 * g + 4 * hi;
            const f32x4 gg = *(const f32x4*)(subln + dd);
            u32x2 w; w.x = cvt_pk_bf16(o0[d][4 * g + 0] * rs * gg[0], o0[d][4 * g + 1] * rs * gg[1]); w.y = cvt_pk_bf16(o0[d][4 * g + 2] * rs * gg[2], o0[d][4 * g + 3] * rs * gg[3]);
            *(u32x2*)(orow + dd) = w;
        }
}

constexpr int HY_F1 = 32832, HY_U = 66048;
__device__ __forceinline__ void hyena_item(LAS unsigned char* lds, const bf16_t* FILT  , const bf16_t* XTp, const float* cw, const float* cb, bf16_t* YT, int c, int L) {
    int tid = threadIdx.x; asm volatile("" : "+v"(tid));
    const int lane = tid & 63, r32 = lane & 31, hi = lane >> 5; const int wid = __builtin_amdgcn_readfirstlane(tid >> 6);
    const int NB = L >> 5, B = CH / L, G = 32 / B, gsh = (B == 2) ? 4 : 3, APAD = 4 * G, NBP = NB + 8 * G + 4, QP = NBP >> 2, BS = 16 * QP + 8;
    __syncthreads();
    {
        const int npc = (2 * L * 2) / 16;
        const u32x4* src = (const u32x4*)(FILT + (size_t)c * 4 * L);
        for (int q = tid; q < 2 * npc; q += 512) {
            const int cp = q >= npc; const int qq = cp ? q - npc : q;
            *(LAS u32x4*)(lds + (cp ? HY_F1 : 0) + qq * 16) = src[q];
        }
        const bf16_t* x1t = XTp + (size_t)c * CH; const bf16_t* hvt = XTp + (size_t)(1024 + c) * CH;
        const float wx0 = cw[1024 + c], wx1 = cw[3072 + 1024 + c], wx2 = cw[6144 + 1024 + c], bx = cb[1024 + c];
        const float wh0 = cw[2048 + c], wh1 = cw[3072 + 2048 + c], wh2 = cw[6144 + 2048 + c], bh = cb[2048 + c];
        for (int q = tid; q < CH / 8; q += 512) {
            const int tk = q * 8, b = tk / L, pos = tk - b * L, a = pos >> 5, r = (pos >> 3) & 3;
            const u32x4 xw = *(const u32x4*)(x1t + tk), hw = *(const u32x4*)(hvt + tk);
            const float px = pos > 0 ? bf2f(x1t[tk - 1]) : 0.f, ph = pos > 0 ? bf2f(hvt[tk - 1]) : 0.f;
            const float nx = pos + 8 < L ? bf2f(x1t[tk + 8]) : 0.f, nh = pos + 8 < L ? bf2f(hvt[tk + 8]) : 0.f;
            float xs[10], hs[10];
            xs[0] = px; xs[1] = bflo(xw.x); xs[2] = bfhi(xw.x); xs[3] = bflo(xw.y); xs[4] = bfhi(xw.y); xs[5] = bflo(xw.z); xs[6] = bfhi(xw.z); xs[7] = bflo(xw.w); xs[8] = bfhi(xw.w); xs[9] = nx;
            hs[0] = ph; hs[1] = bflo(hw.x); hs[2] = bfhi(hw.x); hs[3] = bflo(hw.y); hs[4] = bfhi(hw.y); hs[5] = bflo(hw.z); hs[6] = bfhi(hw.z); hs[7] = bflo(hw.w); hs[8] = bfhi(hw.w); hs[9] = nh;
            float u[8];
#pragma unroll
            for (int e = 0; e < 8; ++e) u[e] = (wx0 * xs[e] + wx1 * xs[e + 1] + wx2 * xs[e + 2] + bx) * (wh0 * hs[e] + wh1 * hs[e + 1] + wh2 * hs[e + 2] + bh);
            u32x4 uw; uw.x = cvt_pk_bf16(u[0], u[1]); uw.y = cvt_pk_bf16(u[2], u[3]); uw.z = cvt_pk_bf16(u[4], u[5]); uw.w = cvt_pk_bf16(u[6], u[7]);
            { const int idx = APAD + a; *(LAS u32x4*)(lds + HY_U + (b * BS + (r * 4 + (idx & 3)) * QP + (idx >> 2)) * 16) = uw; }
        }
        const int npad = 8 * G + 4, nz = 4 * B * npad;
        for (int z = tid; z < nz; z += 512) {
            const int plane = z / npad, w_ = z - plane * npad; const int idx = (w_ < APAD) ? w_ : NB + w_;
            *(LAS u32x4*)(lds + HY_U + ((plane >> 2) * BS + ((plane & 3) * 4 + (idx & 3)) * QP + (idx >> 2)) * 16) = zero4();
        }
    }
    __syncthreads();
    {
    const int wq = wid & 3, half = wid >> 2;
    f32x16 acc0, acc1, acc2, acc3;
#pragma unroll
    for (int r = 0; r < 16; ++r) { acc0[r] = 0.f; acc1[r] = 0.f; acc2[r] = 0.f; acc3[r] = 0.f; }
    const int bn = r32 >> gsh, iblk = r32 & (G - 1);
    const int Ib = G * 4 * wq;
    const int dlo_all = Ib - NB + 1, dhi_all = Ib + 4 * G - 1, dmid = dlo_all + ((dhi_all - dlo_all + 1) >> 1);
    const int dlo = half ? dmid : dlo_all, dhi = half ? dhi_all : dmid - 1;
#define HY_LOADA(P, DL) do { \
        _Pragma("unroll") for (int kh = 0; kh < 2; ++kh) { \
            const int x0 = L - 32 * (DL) + 16 * kh + 8 * hi - r32; const int cp = x0 & 1; const int xe = x0 - cp; \
            const LAS unsigned* fp = (const LAS unsigned*)(lds + (cp ? HY_F1 : 0)) + (xe >> 1); \
            P##a[kh].x = fp[0]; P##a[kh].y = fp[1]; P##a[kh].z = fp[2]; P##a[kh].w = fp[3]; } } while (0)
#define HY_LOADB(P, DL) do { \
        const int ix = Ib + APAD - (DL); \
        _Pragma("unroll") for (int kh = 0; kh < 2; ++kh) \
            P##b[kh] = *(const LAS u32x4*)(lds + HY_U + (bn * BS + ((2 * kh + hi) * 4 + (ix & 3)) * QP + (ix >> 2) + iblk) * 16); } while (0)
#define HY_CL(x) ((x) <= dhi ? (x) : dhi)
#define HY_LD(P, DL) do { const int d_ = HY_CL(DL); HY_LOADA(P, d_); HY_LOADB(P, d_); } while (0)
#define HY_MMA4(P, Q1, Q2, Q3) do { \
        _Pragma("unroll") for (int kh = 0; kh < 2; ++kh) { \
            acc0 = __builtin_amdgcn_mfma_f32_32x32x16_bf16(__builtin_bit_cast(bf16x8, P##a[kh]), __builtin_bit_cast(bf16x8, P##b[kh]), acc0, 0, 0, 0); \
            acc1 = __builtin_amdgcn_mfma_f32_32x32x16_bf16(__builtin_bit_cast(bf16x8, P##a[kh]), __builtin_bit_cast(bf16x8, Q1##b[kh]), acc1, 0, 0, 0); \
            acc2 = __builtin_amdgcn_mfma_f32_32x32x16_bf16(__builtin_bit_cast(bf16x8, P##a[kh]), __builtin_bit_cast(bf16x8, Q2##b[kh]), acc2, 0, 0, 0); \
            acc3 = __builtin_amdgcn_mfma_f32_32x32x16_bf16(__builtin_bit_cast(bf16x8, P##a[kh]), __builtin_bit_cast(bf16x8, Q3##b[kh]), acc3, 0, 0, 0); } } while (0)
#define HY_SB() __builtin_amdgcn_sched_barrier(0)
    u32x4 P0a[2], P0b[2], P1a[2], P1b[2], P2a[2], P2b[2], P3a[2], P3b[2], P4a[2], P4b[2];
    HY_LOADB(P4, dlo - 1); HY_LOADB(P3, dlo - 2); HY_LOADB(P2, dlo - 3);
    HY_LD(P0, dlo);
    int dl = dlo;
    for (; dl + 4 <= dhi; dl += 5) {
        HY_SB(); HY_LD(P1, dl + 1); HY_SB(); HY_MMA4(P0, P4, P3, P2);
        HY_SB(); HY_LD(P2, dl + 2); HY_SB(); HY_MMA4(P1, P0, P4, P3);
        HY_SB(); HY_LD(P3, dl + 3); HY_SB(); HY_MMA4(P2, P1, P0, P4);
        HY_SB(); HY_LD(P4, dl + 4); HY_SB(); HY_MMA4(P3, P2, P1, P0);
        HY_SB(); HY_LD(P0, dl + 5); HY_SB(); HY_MMA4(P4, P3, P2, P1);
    }
    HY_SB();
    if (dl <= dhi)     { HY_LD(P1, dl + 1); HY_MMA4(P0, P4, P3, P2); }
    if (dl + 1 <= dhi) { HY_LD(P2, dl + 2); HY_MMA4(P1, P0, P4, P3); }
    if (dl + 2 <= dhi) { HY_LD(P3, dl + 3); HY_MMA4(P2, P1, P0, P4); }
    if (dl + 3 <= dhi) { HY_MMA4(P3, P2, P1, P0); }
#undef HY_LOADA
#undef HY_LOADB
#undef HY_CL
#undef HY_LD
#undef HY_MMA4
#undef HY_SB
    __syncthreads();
    LAS float* stash = (LAS float*)lds + (wq * 64) * 64 + lane;
    if (half) {
#pragma unroll
        for (int r = 0; r < 16; ++r) { stash[(r) * 64] = acc0[r]; stash[(16 + r) * 64] = acc1[r]; stash[(32 + r) * 64] = acc2[r]; stash[(48 + r) * 64] = acc3[r]; }
    }
    __syncthreads();
    if (!half) {
#pragma unroll
        for (int r = 0; r < 16; ++r) { acc0[r] += stash[(r) * 64]; acc1[r] += stash[(16 + r) * 64]; acc2[r] += stash[(32 + r) * 64]; acc3[r] += stash[(48 + r) * 64]; }
        bf16_t* yb = YT + (size_t)c * CH + bn * L + 32 * (Ib + 4 * iblk) + 4 * hi;
#pragma unroll
        for (int g = 0; g < 4; ++g) {
            u32x2 w;
            w.x = cvt_pk_bf16(acc0[4 * g + 0], acc0[4 * g + 1]); w.y = cvt_pk_bf16(acc0[4 * g + 2], acc0[4 * g + 3]); *(u32x2*)(yb + 8 * g) = w;
            w.x = cvt_pk_bf16(acc1[4 * g + 0], acc1[4 * g + 1]); w.y = cvt_pk_bf16(acc1[4 * g + 2], acc1[4 * g + 3]); *(u32x2*)(yb + 32 + 8 * g) = w;
            w.x = cvt_pk_bf16(acc2[4 * g + 0], acc2[4 * g + 1]); w.y = cvt_pk_bf16(acc2[4 * g + 2], acc2[4 * g + 3]); *(u32x2*)(yb + 64 + 8 * g) = w;
            w.x = cvt_pk_bf16(acc3[4 * g + 0], acc3[4 * g + 1]); w.y = cvt_pk_bf16(acc3[4 * g + 2], acc3[4 * g + 3]); *(u32x2*)(yb + 96 + 8 * g) = w;
        }
    }
    }
}

__device__ __forceinline__ void conv8(const bf16_t* src, int pitch, bool hasp, bool hasn, const float* w, int C, const float* b, float (&o)[8]) {
    const u32x4 z = zero4();
    const u32x4 cu = *(const u32x4*)src; const u32x4 pv = hasp ? *(const u32x4*)(src - pitch) : z; const u32x4 nx = hasn ? *(const u32x4*)(src + pitch) : z;
    const f32x4 w0a = *(const f32x4*)(w), w0b = *(const f32x4*)(w + 4), w1a = *(const f32x4*)(w + C), w1b = *(const f32x4*)(w + C + 4), w2a = *(const f32x4*)(w + 2 * C), w2b = *(const f32x4*)(w + 2 * C + 4);
    const f32x4 ba = *(const f32x4*)b, bb = *(const f32x4*)(b + 4);
    o[0] = w0a[0] * bflo(pv.x) + w1a[0] * bflo(cu.x) + w2a[0] * bflo(nx.x) + ba[0];
    o[1] = w0a[1] * bfhi(pv.x) + w1a[1] * bfhi(cu.x) + w2a[1] * bfhi(nx.x) + ba[1];
    o[2] = w0a[2] * bflo(pv.y) + w1a[2] * bflo(cu.y) + w2a[2] * bflo(nx.y) + ba[2];
    o[3] = w0a[3] * bfhi(pv.y) + w1a[3] * bfhi(cu.y) + w2a[3] * bfhi(nx.y) + ba[3];
    o[4] = w0b[0] * bflo(pv.z) + w1b[0] * bflo(cu.z) + w2b[0] * bflo(nx.z) + bb[0];
    o[5] = w0b[1] * bfhi(pv.z) + w1b[1] * bfhi(cu.z) + w2b[1] * bfhi(nx.z) + bb[1];
    o[6] = w0b[2] * bflo(pv.w) + w1b[2] * bflo(cu.w) + w2b[2] * bflo(nx.w) + bb[2];
    o[7] = w0b[3] * bfhi(pv.w) + w1b[3] * bfhi(cu.w) + w2b[3] * bfhi(nx.w) + bb[3];
}


#define XB_TMO      128
#define XB_XCNT(j)  (256  + 64 * (j))
#define XB_XSUB(j)  (1280 + 64 * (j))
#define XB_XGEN(j)  (2304 + 64 * (j))
#define XB_TOP      3328
#define XB_TOPGEN   3392
#define XCD_BAR_WORDS 3456
#define XB_SPIN_CAP (1u << 18)
__device__ __forceinline__ unsigned xb_ld(unsigned* p)              { return __hip_atomic_load(p, __ATOMIC_RELAXED, __HIP_MEMORY_SCOPE_AGENT); }
__device__ __forceinline__ unsigned xb_add(unsigned* p, unsigned v) { return __hip_atomic_fetch_add(p, v, __ATOMIC_RELAXED, __HIP_MEMORY_SCOPE_AGENT); }
__device__ __forceinline__ unsigned xb_xcc_id() { return (unsigned)__builtin_amdgcn_s_getreg((3 << 11) | 20) & 0xFu; }
#define XB_SPIN(cond, bar) do { unsigned _sp = 0; while (cond) { __builtin_amdgcn_s_sleep(1); \
    if ((++_sp & 255u) == 0u) { if (xb_ld(&(bar)[XB_TMO])) break; if (_sp > XB_SPIN_CAP) { atomicAdd(&(bar)[XB_TMO], 1u); break; } } } } while (0)
__device__ __forceinline__ void xcd_barrier_complete(unsigned* bar, unsigned x, unsigned& nloc, unsigned& nx) {
    const unsigned G = gridDim.x * gridDim.y * gridDim.z;
    unsigned sum, cnt, mine, sp = 0u;
    for (;;) {
        sum = 0u; cnt = 0u; mine = 0u;
#pragma unroll
        for (unsigned j = 0; j < 16; ++j) { const unsigned c = xb_ld(&bar[XB_XCNT(j)]); sum += c; cnt += (c > 0u) ? 1u : 0u; mine = (j == x) ? c : mine; }
        if (sum == G) break;
        __builtin_amdgcn_s_sleep(1);
        if ((++sp & 255u) == 0u) { if (xb_ld(&bar[XB_TMO])) break; if (sp > XB_SPIN_CAP) { atomicAdd(&bar[XB_TMO], 1u); break; } }
    }
    nloc = mine > 0u ? mine : 1u; nx = cnt > 0u ? cnt : 1u;
}
__device__ __forceinline__ void xcd_barrier(unsigned* bar, volatile LAS unsigned* st) {
    asm volatile("s_waitcnt vmcnt(0)" ::: "memory");
    __syncthreads();
    if (threadIdx.x == 0) {
        const unsigned x = xb_xcc_id();
        __builtin_amdgcn_s_waitcnt(0);
        unsigned nloc = st[0], nx = st[1];
        if (nloc == 0u) { xcd_barrier_complete(bar, x, nloc, nx); st[0] = nloc; st[1] = nx; }
        const unsigned old = xb_add(&bar[XB_XSUB(x)], 1u);
        const unsigned gen = old / nloc;
        if (old + 1u == (gen + 1u) * nloc) {
            __builtin_amdgcn_fence(__ATOMIC_RELEASE, "agent");
            asm volatile("s_waitcnt vmcnt(0)" ::: "memory");
            const unsigned og = xb_add(&bar[XB_TOP], 1u);
            const unsigned tg = og / nx;
            if (og + 1u == (tg + 1u) * nx) xb_add(&bar[XB_TOPGEN], 1u);
            else XB_SPIN(xb_ld(&bar[XB_TOPGEN]) == tg, bar);
            __builtin_amdgcn_fence(__ATOMIC_ACQUIRE, "agent");
            xb_add(&bar[XB_XGEN(x)], 1u);
            asm volatile("s_waitcnt vmcnt(0)" ::: "memory");
        } else {
            XB_SPIN(xb_ld(&bar[XB_XGEN(x)]) == gen, bar);
            __builtin_amdgcn_fence(__ATOMIC_ACQUIRE, "agent");
            asm volatile("s_waitcnt vmcnt(0)" ::: "memory");
        }
    }
    __syncthreads();
}

#ifndef PHMASK
#define PHMASK 0xFFFFu
#endif
#ifndef REPMASK
#define REPMASK 0u
#endif
#define MISC_OFF 147392
#define GSYNC() do { kparams_t KPb = kparams(); xcd_barrier((unsigned*)(KPb->ws + WS_CTL), (volatile LAS unsigned*)(lds + MISC_OFF)); } while (0)
#define REPS(k) for (int rep_ = 0; rep_ < 1 + (int)((REPMASK >> (k)) & 1u); ++rep_)
constexpr int LDS_BYTES = 147456;
typedef const __attribute__((address_space(4))) Params* kparams_t;
__device__ __forceinline__ kparams_t kparams() { kparams_t p = (kparams_t)__builtin_amdgcn_kernarg_segment_ptr(); asm volatile("" : "+s"(p)); return p; }
#define PIN(i) ((const float*)KP->in[i])
__device__ __forceinline__ const float* xin_ptr(kparams_t KP, int chunk) { int c = chunk; asm volatile("" : "+s"(c)); return c == 0 ? (const float*)KP->in[0] : (const float*)KP->in[1] + ((size_t)(c - 1) << 25); }
__device__ __forceinline__ float* outc_ptr(kparams_t KP, int chunk) { int c = chunk; asm volatile("" : "+s"(c)); return (float*)KP->out + ((size_t)c << 25); }
#define WSB(off) ((bf16_t*)(ws + (off)))
#define WSF(off) ((float*)(ws + (off)))
#define PHASE_BEGIN kparams_t KP = kparams(); unsigned char* ws = KP->ws; (void)ws; int tid = threadIdx.x; asm volatile("" : "+v"(tid)); const int lane = tid & 63; const int wid = __builtin_amdgcn_readfirstlane(tid >> 6); const int gw = bid * 8 + wid; (void)lane; (void)gw;
#define PART1 WSF(WS_PART1)
#define PART2 WSF(WS_PART2)
#define RSTD1 WSF(WS_RSTD1)
#define ROPE ((f32x2*)(ws + WS_ROPE))
#define H3 WSF(WS_H3)
#define WIN WSB(WS_WIN)
#define WUP WSB(WS_WUP)
#define WDN WSB(WS_WDN)
#define WOUT WSB(WS_WOUT)
#define WA WSB(WS_WA)
#define WH WSB(WS_WH)
#define F4 WSB(WS_F4)
#define F8 WSB(WS_F8)
#define XB WSB(WS_XB)
#define MG WSB(WS_R23)
#define X1B WSB(WS_R1 + R1_UT)
#define X2B WSB(WS_R1 + R1_UT)
#define ACT WSB(WS_R23)
#define QB WSB(WS_R1 + R1_QB)
#define KB WSB(WS_R1 + R1_KB)
#define VB WSB(WS_R1 + R1_VB)
#define HY WSB(WS_R1 + R1_HY)
#define GT WSB(WS_R1 + R1_GT)
#define AT WSB(WS_R1 + R1_AT)
#define HN WSB(WS_R1 + R1_HN)
#define UT WSB(WS_R1 + R1_UT)
#define YT WSB(WS_R1 + R1_YT)
#define XT WSB(WS_R1 + R1_XT)
#define T1 WSB(WS_R1 + R1_QB)
#define UP WSB(WS_R1 + R1_QB)
#define BODY_PA(CK) do { const float* xin_ = xin_ptr(KP, (CK)); \
        for (int row = gw; row < CH; row += NGW) { \
            const f32x4* xr = (const f32x4*)(xin_ + (size_t)row * DM) + lane; \
            f32x4 v[8]; float s = 0.f; \
            _Pragma("unroll") for (int j = 0; j < 8; ++j) { v[j] = __builtin_nontemporal_load(xr + 64 * j); s += (v[j][0] * v[j][0] + v[j][1] * v[j][1]) + (v[j][2] * v[j][2] + v[j][3] * v[j][3]); } \
            s = wave_sum(s, lane); \
            if (lane == 0) RSTD1[row] = rsqrtf(s * (1.0f / DM) + EPS); \
            u32x2* o = (u32x2*)(XB + (size_t)row * DM) + lane; \
            _Pragma("unroll") for (int j = 0; j < 8; ++j) { u32x2 w; w.x = cvt_pk_bf16(v[j][0], v[j][1]); w.y = cvt_pk_bf16(v[j][2], v[j][3]); o[64 * j] = w; } \
        } } while (0)
#define BODY_FINAL(CK) do { const float* nf = PIN(29); float* outc_ = outc_ptr(KP, (CK)); \
        for (int row = gw; row < CH; row += NGW) { \
            float s = (lane < 32) ? PART2[(size_t)row * 32 + lane] : 0.f; \
            s = wave_sum(s, lane); \
            const float rs = rsqrtf(s * (1.0f / DM) + EPS); \
            const u32x4* xr = (const u32x4*)(X2B + (size_t)row * DM) + lane; f32x4* orow = (f32x4*)(outc_ + (size_t)row * DM); const f32x4* gr = (const f32x4*)nf; \
            _Pragma("unroll") for (int j = 0; j < 4; ++j) { \
                const u32x4 w = xr[64 * j]; const int e4 = 2 * (lane + 64 * j); \
                const f32x4 g0 = gr[e4], g1 = gr[e4 + 1]; \
                __builtin_nontemporal_store((f32x4){bflo(w.x) * rs * g0[0], bfhi(w.x) * rs * g0[1], bflo(w.y) * rs * g0[2], bfhi(w.y) * rs * g0[3]}, orow + e4); \
                __builtin_nontemporal_store((f32x4){bflo(w.z) * rs * g1[0], bfhi(w.z) * rs * g1[1], bflo(w.w) * rs * g1[2], bfhi(w.w) * rs * g1[3]}, orow + e4 + 1); \
            } } } while (0)
__global__ void __launch_bounds__(512, 2) mega_fwd(Params P) {
    extern __shared__ __attribute__((aligned(16))) unsigned char lds_raw[];
    LAS unsigned char* lds = (LAS unsigned char*)lds_raw;
    cg::grid_group grid = cg::this_grid();
    const int G = gridDim.x, bid = blockIdx.x;
    const int NGW = G * 8;
    if (threadIdx.x < 2) ((volatile LAS unsigned*)(lds + MISC_OFF))[threadIdx.x] = 0u;
    { kparams_t KPb = kparams(); if (threadIdx.x == 0) (void)xb_add(&((unsigned*)(KPb->ws + WS_CTL))[XB_XCNT(xb_xcc_id())], 1u); }
    __syncthreads();
    if (PHMASK & (1u << 0)) { PHASE_BEGIN
        LAS float* scr = (LAS float*)(lds + wid * 16640);
        constexpr int I_IN = 32 * 160, I_UP = 32 * 176, I_DN = 88 * 32, I_OUT = 32 * 32, I_A = 16 * 32;
        constexpr int NIT = I_IN + I_UP + I_DN + I_OUT + 2 * I_A;
        REPS(0) for (int it = gw; it < NIT; it += NGW) {
            int r = it;
            if (r < I_IN) { transpose_item(PIN(3), DM, INW, WIN, PIN(2), true, scr, r, lane); continue; } r -= I_IN;
            if (r < I_UP) { transpose_item(PIN(25), DM, UPW, WUP, PIN(24), false, scr, r, lane); continue; } r -= I_UP;
            if (r < I_DN) { transpose_item(PIN(28), DFF, DM, WDN, nullptr, false, scr, r, lane); continue; } r -= I_DN;
            if (r < I_OUT) { transpose_item(PIN(23), DM, DM, WOUT, nullptr, false, scr, r, lane); continue; } r -= I_OUT;
            if (r < I_A) { transpose_item(PIN(21), 1024, DM, WA, nullptr, false, scr, r, lane, 2048, 0); continue; } r -= I_A;
            transpose_item(PIN(22), 1024, DM, WA, nullptr, false, scr, r, lane, 2048, 1024);
        }
        REPS(0) for (int e = bid * 512 + tid; e < 8192 * 32; e += G * 512) {
            const int pos = e >> 5, i = e & 31;
            const float inv = (float)exp2(-(double)(2 * i) / 64.0 * 13.287712379549449);
            const float ang = (float)pos * inv;
            double s, c; sincos_d((double)ang, s, c);
            ROPE[e] = (f32x2){(float)c, (float)s};
        }
        const float* w1 = PIN(12); const float* b1 = PIN(13); const float* w2 = PIN(14); const float* b2 = PIN(15); const float* w3 = PIN(16); const float* b3 = PIN(17); const float* fq_ = PIN(19);
        const float fr = fq_[lane];
        REPS(0) for (int it = gw; it < 4096 + 8192; it += NGW) {
            const int L = it < 4096 ? 4096 : 8192, t = it < 4096 ? it : it - 4096;
            const float tn = (float)t / (float)(L - 1);
            const float w = 6.283185307179586f * (float)t / (float)L;
            float z = 0.f;
            if (lane == 0) z = tn;
            else if (lane <= 32) {
                const int k = (lane - 1) & 15;
                const float f = 1e-4f + (float)k * ((15.0f - 1e-4f) / 15.0f);
                double s, c; sincos_d((double)(f * w), s, c);
                z = (lane <= 16) ? (float)c : (float)(-s);
            }
            float a = b1[lane];
#pragma unroll 11
            for (int e = 0; e < 33; ++e) a += __shfl(z, e) * w1[e * 64 + lane];
            float h = sin_f(fr * a);
            a = b2[lane];
#pragma unroll 16
            for (int e = 0; e < 64; ++e) a += __shfl(h, e) * w2[e * 64 + lane];
            h = sin_f(fr * a);
            a = b3[lane];
#pragma unroll 16
            for (int e = 0; e < 64; ++e) a += __shfl(h, e) * w3[e * 64 + lane];
            h = sin_f(fr * a);
            H3[(size_t)it * 64 + lane] = h;
        }
    }
    grid.sync();
    if (PHMASK & (1u << 1)) { PHASE_BEGIN
        const float* w4 = PIN(18); const float* hb = PIN(20);
        const int NI4 = 64 * 256, NI8 = 128 * 256;
        REPS(1) for (int it = gw; it < NI4 + NI8; it += NGW) {
            const bool is8 = it >= NI4; const int L = is8 ? 8192 : 4096; const int r = is8 ? it - NI4 : it;
            const int tb = r >> 8, cg8 = r & 255; const int t = tb * 64 + lane;
            const float* hrow = H3 + (size_t)((is8 ? 4096 : 0) + t) * 64;
            bf16_t* Fb = is8 ? F8 : F4;
            const float tn = (float)t / (float)(L - 1);
            float acc8[8];
#pragma unroll
            for (int cc = 0; cc < 8; ++cc) acc8[cc] = 0.f;
#pragma unroll 2
            for (int jb = 0; jb < 16; ++jb) {
                const f32x4 h4 = *(const f32x4*)(hrow + 4 * jb);
#pragma unroll
                for (int jj = 0; jj < 4; ++jj) {
                    const f32x4 wa = *(const f32x4*)(w4 + (4 * jb + jj) * 2048 + cg8 * 8), wb = *(const f32x4*)(w4 + (4 * jb + jj) * 2048 + cg8 * 8 + 4);
#pragma unroll
                    for (int e = 0; e < 4; ++e) { acc8[e] += h4[jj] * wa[e]; acc8[4 + e] += h4[jj] * wb[e]; }
                }
            }
#pragma unroll
            for (int cc = 0; cc < 8; ++cc) {
                const int cp = cg8 * 8 + cc;
                const float a = acc8[cc];
                const int c = cp & 1023; const bool bwd = cp >= 1024;
                const float mind = -3.0701134573253946f, maxd = -15.350567286626973f;
                const float delta = fabsf(mind + (float)c * ((maxd - mind) / 1023.0f));
                float val = a * __expf(-tn * delta);
                bf16_t* f0 = Fb + (size_t)c * 4 * L; bf16_t* f1 = f0 + 2 * L;
                if (!bwd) { if (t == 0) val += hb[c]; const int x = L - t; const bf16_t v = (bf16_t)f2bf(val); f0[x] = v; f1[x - 1] = v; }
                else if (t > 0) { const int x = L + t; const bf16_t v = (bf16_t)f2bf(val); f0[x] = v; f1[x - 1] = v; }
                else { f0[0] = 0; f1[2 * L - 1] = 0; }
            }
        }
    }

    if (PHMASK & (1u << 2)) { PHASE_BEGIN BODY_PA(0); }
#pragma unroll 1
    for (int chunk = 0; chunk < NCHUNK; ++chunk) {
        const int L = chunk == 0 ? 4096 : 8192;
#define xin xin_ptr(KP, chunk)
#define outc outc_ptr(KP, chunk)
#define FILT (chunk == 0 ? F4 : F8)
        GSYNC();
        if (PHMASK & (1u << 3)) { PHASE_BEGIN
#pragma unroll 1
            for (int step = 0; step < 2; ++step) {
                if ((step == 0) != ((bid & 1) != 0)) {
                    pg8::Gemm g{XB, WIN, CH, INW, DM}; pg8::StaticOrder S; S.init(CH, INW, G, bid);
                    Epi1 E{QB, KB, VB, HY, GT, XT, RSTD1, PIN(6), ROPE, L};
                    REPS(3) pg8::gemm_phase<Epi1, true>(lds, g, S, E);
                } else if (chunk > 0) { BODY_FINAL(chunk - 1); }
            }
        }
        GSYNC();
        if (PHMASK & (1u << 5)) { PHASE_BEGIN
            const int nqb = L / 256;
            float lam;
            { const float a = wave_sum(PIN(7)[lane] * PIN(8)[lane], lane), b = wave_sum(PIN(9)[lane] * PIN(10)[lane], lane); lam = __expf(a) - __expf(b) + LAMBDA_INIT; }
            const int vb = (G == 256) ? ((bid & 7) * 32 + (bid >> 3)) : bid;
            REPS(5) for (int it0 = vb; it0 < 512; it0 += G) {
                const int it = it0; const int nqsh = (L == 4096) ? 4 : 5; const int qb = it & (nqb - 1), sh = it >> nqsh, h = sh & 7, s = sh >> 3;
                attn_item(lds, QB, KB, VB, AT, s * L, h, qb, L, lam, PIN(11));
            }
            REPS(13) for (int c = bid; c < 1024; c += G) hyena_item(lds, FILT, XT, PIN(4), PIN(5), YT, c, L);
            __syncthreads();
        }
        GSYNC();
        if (PHMASK & (1u << 6)) { PHASE_BEGIN
            const float* cw = PIN(4); const float* cb = PIN(5);
            LAS bf16_t* tl = (LAS bf16_t*)lds;
            for (int tix = bid; tix < 4096; tix += G) {
                const int tb = tix >> 4, cbk = tix & 15;
                { const int ch = tid >> 3, seg = tid & 7; *(LAS u32x4*)(tl + ch * 72 + seg * 8) = *(const u32x4*)(YT + (size_t)(cbk * 64 + ch) * CH + tb * 64 + seg * 8); }
                __syncthreads();
                const int tr = tid >> 3, tc = tid & 7; const int tok = tb * 64 + tr, pos = tok & (L - 1), c0 = cbk * 64 + tc * 8;
                float a[8];
                conv8(HY + (size_t)tok * 3072 + c0, 3072, pos > 0, pos < L - 1, cw + c0, 3072, cb + c0, a);
                u32x4 w;
                w.x = cvt_pk_bf16(a[0] * bf2f(tl[(tc * 8 + 0) * 72 + tr]), a[1] * bf2f(tl[(tc * 8 + 1) * 72 + tr]));
                w.y = cvt_pk_bf16(a[2] * bf2f(tl[(tc * 8 + 2) * 72 + tr]), a[3] * bf2f(tl[(tc * 8 + 3) * 72 + tr]));
                w.z = cvt_pk_bf16(a[4] * bf2f(tl[(tc * 8 + 4) * 72 + tr]), a[5] * bf2f(tl[(tc * 8 + 5) * 72 + tr]));
                w.w = cvt_pk_bf16(a[6] * bf2f(tl[(tc * 8 + 6) * 72 + tr]), a[7] * bf2f(tl[(tc * 8 + 7) * 72 + tr]));
                *(u32x4*)(AT + (size_t)tok * 2048 + 1024 + c0) = w;
                __syncthreads();
            }
        }
        GSYNC();
        if (PHMASK & (1u << 7)) { PHASE_BEGIN
            pg8::Gemm g{AT, WA, CH, DM, DM}; pg8::StaticOrder S; S.init(CH, DM, G, bid);
            Epi2M E{GT, MG};
            pg8::gemm_phase<Epi2M, true>(lds, g, S, E);
        }
        GSYNC();
        if (PHMASK & (1u << 8)) { PHASE_BEGIN
            pg8::Gemm g{MG, WOUT, CH, DM, DM}; pg8::StaticOrder S; S.init(CH, DM, G, bid);
            EpiResB E{XB, X1B, PART1};
            pg8::gemm_phase<EpiResB, true>(lds, g, S, E);
        }
        GSYNC();
        if (PHMASK & (1u << 9)) { PHASE_BEGIN
#pragma unroll 1
            for (int step = 0; step < 2; ++step) {
                if ((step == 0) != ((bid & 1) != 0)) {
                    pg8::Gemm g{X1B, WUP, CH, UPW, DM}; pg8::StaticOrder S; S.init(CH, UPW, G, bid);
                    Epi4 E{UP, PART1};
                    REPS(9) pg8::gemm_phase<Epi4, true>(lds, g, S, E);
                } else if (chunk + 1 < NCHUNK) { BODY_PA(chunk + 1); }
            }
        }
        GSYNC();
        if (PHMASK & (1u << 10)) { PHASE_BEGIN
            const float* cw = PIN(26); const float* cb = PIN(27);
            const int nitems = (CH / 16) * 704;
            REPS(10) for (int it = bid * 512 + tid; it < nitems; it += G * 512) {
                const int cgp = it % 704, rb = it / 704; const int c0 = cgp * 8, r0 = rb * 16; const int pos0 = r0 & (L - 1);
                float wg[3][8], wv[3][8], bg[8], bv[8];
#pragma unroll
                for (int j = 0; j < 3; ++j) {
                    const f32x4 a0 = *(const f32x4*)(cw + j * UPW + c0), a1 = *(const f32x4*)(cw + j * UPW + c0 + 4), b0 = *(const f32x4*)(cw + j * UPW + DFF + c0), b1 = *(const f32x4*)(cw + j * UPW + DFF + c0 + 4);
#pragma unroll
                    for (int e = 0; e < 4; ++e) { wg[j][e] = a0[e]; wg[j][4 + e] = a1[e]; wv[j][e] = b0[e]; wv[j][4 + e] = b1[e]; }
                }
                { const f32x4 a0 = *(const f32x4*)(cb + c0), a1 = *(const f32x4*)(cb + c0 + 4), b0 = *(const f32x4*)(cb + DFF + c0), b1 = *(const f32x4*)(cb + DFF + c0 + 4);
#pragma unroll
                  for (int e = 0; e < 4; ++e) { bg[e] = a0[e]; bg[4 + e] = a1[e]; bv[e] = b0[e]; bv[4 + e] = b1[e]; } }
                const bf16_t* up = UP + (size_t)r0 * UPW + c0;
                const u32x4 z4 = zero4();
                u32x4 pg = (pos0 > 0) ? *(const u32x4*)(up - UPW) : z4, pv = (pos0 > 0) ? *(const u32x4*)(up - UPW + DFF) : z4;
                u32x4 cg_ = *(const u32x4*)up, cv = *(const u32x4*)(up + DFF);
#pragma unroll 4
                for (int rr = 0; rr < 16; ++rr) {
                    const bool hn = (pos0 + rr) < L - 1;
                    const u32x4 ng = hn ? __builtin_nontemporal_load((const u32x4*)(up + (size_t)(rr + 1) * UPW)) : z4, nv = hn ? __builtin_nontemporal_load((const u32x4*)(up + (size_t)(rr + 1) * UPW + DFF)) : z4;
                    float o[8];
#define ACT1(e, PW, CW, NW, PV_, CV_, NV_, SEL) { const float g = wg[0][e] * SEL(PW) + wg[1][e] * SEL(CW) + wg[2][e] * SEL(NW) + bg[e]; const float v = wv[0][e] * SEL(PV_) + wv[1][e] * SEL(CV_) + wv[2][e] * SEL(NV_) + bv[e]; o[e] = g / (1.0f + __expf(-g)) * v; }
                    ACT1(0, pg.x, cg_.x, ng.x, pv.x, cv.x, nv.x, bflo) ACT1(1, pg.x, cg_.x, ng.x, pv.x, cv.x, nv.x, bfhi)
                    ACT1(2, pg.y, cg_.y, ng.y, pv.y, cv.y, nv.y, bflo) ACT1(3, pg.y, cg_.y, ng.y, pv.y, cv.y, nv.y, bfhi)
                    ACT1(4, pg.z, cg_.z, ng.z, pv.z, cv.z, nv.z, bflo) ACT1(5, pg.z, cg_.z, ng.z, pv.z, cv.z, nv.z, bfhi)
                    ACT1(6, pg.w, cg_.w, ng.w, pv.w, cv.w, nv.w, bflo) ACT1(7, pg.w, cg_.w, ng.w, pv.w, cv.w, nv.w, bfhi)
#undef ACT1
                    u32x4 w; w.x = cvt_pk_bf16(o[0], o[1]); w.y = cvt_pk_bf16(o[2], o[3]); w.z = cvt_pk_bf16(o[4], o[5]); w.w = cvt_pk_bf16(o[6], o[7]);
                    *(u32x4*)(ACT + (size_t)(r0 + rr) * DFF + c0) = w;
                    pg = cg_; pv = cv; cg_ = ng; cv = nv;
                }
            }
        }
        GSYNC();
        if (PHMASK & (1u << 11)) { PHASE_BEGIN
            pg8::Gemm g{ACT, WDN, CH, DM, DFF}; pg8::StaticOrder S; S.init(CH, DM, G, bid);
            EpiResB E{X1B, X2B, PART2};
            pg8::gemm_phase<EpiResB, true>(lds, g, S, E);
        }
    }
    GSYNC();
    if (PHMASK & (1u << 12)) { PHASE_BEGIN BODY_FINAL(NCHUNK - 1); }
}

extern "C" void kernel_launch(void* const* d_in, const int* in_sizes, int n_in, void* d_out, int out_size, void* d_ws, size_t ws_size, hipStream_t stream) {
    static int grid = 0;
    if (grid == 0) {
        if (n_in != 30 || ws_size < WS_END) { fprintf(stderr, "kernel_launch: unexpected n_in %d or ws_size %zu\n", n_in, ws_size); grid = -1; return; }
        int dev = 0, cus = 0, per_cu = 0;
        (void)hipGetDevice(&dev);
        (void)hipDeviceGetAttribute(&cus, hipDeviceAttributeMultiprocessorCount, dev);
        (void)hipFuncSetAttribute((const void*)mega_fwd, hipFuncAttributeMaxDynamicSharedMemorySize, LDS_BYTES);
        (void)hipOccupancyMaxActiveBlocksPerMultiprocessor(&per_cu, (const void*)mega_fwd, 512, LDS_BYTES);
        (void)hipGetLastError();
        if (per_cu < 1) per_cu = 1;
        grid = cus;
        fprintf(stderr, "kernel_launch: cus %d per_cu %d grid %d\n", cus, per_cu, grid);
    }
    if (grid < 0) return;
    if (hipMemsetAsync((char*)d_ws + WS_CTL, 0, CTL_BYTES, stream) != hipSuccess) { fprintf(stderr, "kernel_launch: memset failed\n"); return; }
    Params p{};
    for (int i = 0; i < 30; ++i) p.in[i] = (const float*)d_in[i];
    p.out = (float*)d_out; p.ws = (unsigned char*)d_ws;
    void* args[] = {&p};
    hipError_t e = hipLaunchCooperativeKernel((const void*)mega_fwd, dim3(grid), dim3(512), args, LDS_BYTES, stream);
    if (e != hipSuccess) fprintf(stderr, "cooperative launch failed: %s (grid %d)\n", hipGetErrorString(e), grid);
}
```

```cpp
#include <hip/hip_runtime.h>
#include <hip/hip_cooperative_groups.h>
#include <cstdio>
#include <cstdint>
namespace cg = cooperative_groups;

#define LAS __attribute__((address_space(3)))
typedef unsigned short bf16_t;
typedef short bf16x8 __attribute__((ext_vector_type(8)));
typedef short s16x4 __attribute__((ext_vector_type(4)));
typedef float f32x2 __attribute__((ext_vector_type(2)));
typedef float f32x4 __attribute__((ext_vector_type(4)));
typedef float f32x16 __attribute__((ext_vector_type(16)));
typedef unsigned u32x2 __attribute__((ext_vector_type(2)));
typedef unsigned u32x4 __attribute__((ext_vector_type(4)));

constexpr int DM = 2048, CH = 16384, NCHUNK = 3;
constexpr int INW = 10240, DFF = 5632, UPW = 11264;
constexpr float EPS = 1e-6f;
constexpr float QSCALE = 0.125f * 1.4426950408889634f;
constexpr float LAMBDA_INIT = 0.2f;

constexpr size_t MiB = 1u << 20;
constexpr size_t WS_PART1 = 0, WS_PART2 = 2 * MiB, WS_RSTD1 = 4 * MiB, WS_ROPE = 5 * MiB, WS_H3 = 7 * MiB;
constexpr size_t WS_WIN = 10 * MiB, WS_WUP = 50 * MiB, WS_WDN = 94 * MiB, WS_WOUT = 116 * MiB, WS_WA = 124 * MiB, WS_WH = 128 * MiB;
constexpr size_t WS_F4 = 132 * MiB, WS_F8 = 164 * MiB;
constexpr size_t WS_R23 = 228 * MiB;
constexpr size_t WS_R1 = 404 * MiB;
constexpr size_t WS_XB = 916 * MiB;
constexpr size_t WS_CTL = 980 * MiB, CTL_BYTES = 16384;
constexpr size_t WS_END = 981 * MiB;
constexpr size_t R1_QB = 0, R1_KB = 32 * MiB, R1_VB = 64 * MiB, R1_HY = 96 * MiB, R1_GT = 192 * MiB, R1_AT = 320 * MiB, R1_HN = 352 * MiB, R1_UT = 384 * MiB, R1_YT = 416 * MiB, R1_XT = 448 * MiB;

struct Params { const float* in[30]; float* out; unsigned char* ws; };

__device__ __forceinline__ float bflo(unsigned w) { return __uint_as_float(w << 16); }
__device__ __forceinline__ float bfhi(unsigned w) { return __uint_as_float(w & 0xffff0000u); }
__device__ __forceinline__ float bf2f(unsigned short h) { return __uint_as_float((unsigned)h << 16); }
__device__ __forceinline__ unsigned f2bf(float f) { unsigned u = __float_as_uint(f); return (u + 0x7fffu + ((u >> 16) & 1u)) >> 16; }
__device__ __forceinline__ unsigned pk2(float lo, float hi) { return f2bf(lo) | (f2bf(hi) << 16); }
typedef __bf16 bf16x2_t __attribute__((ext_vector_type(2)));
__device__ __forceinline__ unsigned cvt_pk_bf16(float lo, float hi) { f32x2 v = {lo, hi}; bf16x2_t b = __builtin_convertvector(v, bf16x2_t); return __builtin_bit_cast(unsigned, b); }
__device__ __forceinline__ float lane_xor_get(float v, int lane, int o) { return __int_as_float(__builtin_amdgcn_ds_bpermute((lane ^ o) << 2, __float_as_int(v))); }
__device__ __forceinline__ float wave_sum(float v, int lane) {
#pragma unroll
    for (int o = 1; o < 64; o <<= 1) v += lane_xor_get(v, lane, o);
    return v;
}
__device__ __forceinline__ float swap_add(float v) { auto rr = __builtin_amdgcn_permlane32_swap(__float_as_uint(v), __float_as_uint(v), false, false); return __uint_as_float(rr[0]) + __uint_as_float(rr[1]); }
__device__ __forceinline__ float swap_max(float v) { auto rr = __builtin_amdgcn_permlane32_swap(__float_as_uint(v), __float_as_uint(v), false, false); return fmaxf(__uint_as_float(rr[0]), __uint_as_float(rr[1])); }
__device__ __forceinline__ u32x4 zero4() { unsigned z = 0u; asm volatile("" : "+v"(z)); return (u32x4){z, z, z, z}; }
__device__ __forceinline__ void sincos_d(double x, double& s, double& c) {
    const double k = rint(x * 0.63661977236758134308);
    double r = fma(-k, 1.57079632679489655800e+00, x);
    r = fma(-k, 6.12323399573676603587e-17, r);
    const double r2 = r * r;
    const double sp = r * (1.0 + r2 * (-1.0 / 6.0 + r2 * (1.0 / 120.0 + r2 * (-1.0 / 5040.0 + r2 * (1.0 / 362880.0 + r2 * (-1.0 / 39916800.0 + r2 * (1.0 / 6227020800.0)))))));
    const double cp = 1.0 + r2 * (-0.5 + r2 * (1.0 / 24.0 + r2 * (-1.0 / 720.0 + r2 * (1.0 / 40320.0 + r2 * (-1.0 / 3628800.0 + r2 * (1.0 / 479001600.0 + r2 * (-1.0 / 87178291200.0)))))));
    const int q = ((int)k) & 3;
    const double ss = (q & 1) ? cp : sp, cc = (q & 1) ? sp : cp;
    s = (q & 2) ? -ss : ss;
    c = ((q + 1) & 2) ? -cc : cc;
}
__device__ __forceinline__ float sin_f(float x) { double s, c; sincos_d((double)x, s, c); return (float)s; }

namespace pg8 {
constexpr int BM = 256, BK = 64, HALF = 128, HTB = HALF * BK * 2, STAGE_BYTES = 8 * HTB, NXCD = 8, WGM = 8;
__host__ __device__ __forceinline__ int lds_byte(int r, int c) { const int st = (r >> 4) * 2 + (c >> 5), rr = r & 15, cc = c & 31, ob = rr * 64 + cc * 2; return st * 1024 + (ob ^ (((ob >> 9) & 1) << 5)); }
__host__ __device__ __forceinline__ void stage_rc(int b, int& R, int& C) { const int st = b / 1024, sb = b % 1024, swz = sb ^ (((sb >> 9) & 1) << 5); R = (st >> 1) * 16 + swz / 64; C = (st & 1) * 32 + (swz % 64) / 2; }
__host__ __device__ __forceinline__ int perm32(int rho) { const int n = rho >> 4, i = rho & 15; return 8 * (i >> 2) + 4 * n + (i & 3); }
struct Unit { int pm, pn; };
struct Gemm { const bf16_t* A; const bf16_t* Bt; int M, N, K; };
struct StaticOrder {
    int nM, nN, nwg, G, c;
    __device__ void init(int M, int N, int G_, int c_) { nM = M / BM; nN = N / BM; nwg = nM * nN; G = G_; c = c_; }
    __device__ bool next(int i, Unit& u) const {
        const long L = (long)i * G + c; if (L >= nwg) return false;
        int wgid = (int)L; { const int q = nwg / NXCD, r = nwg % NXCD, xcd = wgid % NXCD, off = wgid / NXCD; wgid = (xcd < r ? xcd * (q + 1) : r * (q + 1) + (xcd - r) * q) + off; }
        const int nig = WGM * nN, gid = wgid / nig, fm = gid * WGM, gsz = (nM - fm) < WGM ? (nM - fm) : WGM;
        u.pm = fm + ((wgid % nig) % gsz); u.pn = (wgid % nig) / gsz; return true;
    }
};
template <class Epi, bool ALIGN_EPI>
__device__ __forceinline__ void gemm_phase(LAS unsigned char* lds, const Gemm g, const StaticOrder& S, const Epi& E) {
    int tid = threadIdx.x; asm volatile("" : "+v"(tid));
    const int wid = __builtin_amdgcn_readfirstlane(tid >> 6), lane = tid & 63, wr = wid >> 2, wc = wid & 3, fr = lane & 15, fq = lane >> 4;
    const int K = g.K, nt = K / BK;
    unsigned voffA[2], voffB[2];
#pragma unroll
    for (int i = 0; i < 2; ++i) { int R, C; stage_rc(tid * 16 + i * 8192, R, C); const int Rb = Epi::PERM ? ((R & ~31) + perm32(R & 31)) : R;
        voffA[i] = (unsigned)(R * K + C) * 2u; voffB[i] = (unsigned)(Rb * K + C) * 2u; }
    const size_t kstep = (size_t)(BK * 2);
    const size_t hstep = (size_t)HALF * K * 2;
    const size_t tstep = 2 * hstep;
    const unsigned ldsw = (unsigned)wid * 1024u;
    const int aoff = lds_byte(wr * 64 + fr, fq * 8), boff = lds_byte(wc * 32 + fr, fq * 8);
#define PG8_SA(b, h) (((b) * 2 + (h)) * HTB)
#define PG8_SB(b, h) ((4 + (b) * 2 + (h)) * HTB)
#define PG8_STAGE(bufoff, gbase, voff) do { _Pragma("unroll") for (int _i = 0; _i < 2; ++_i) \
        __builtin_amdgcn_global_load_lds((const unsigned*)((const char*)(gbase) + (voff)[_i]), (LAS unsigned*)(lds + (bufoff) + ldsw + _i * 8192), 16, 0, 0); } while (0)
#define PG8_LDA(dst, b, h) do { _Pragma("unroll") for (int m = 0; m < 4; ++m) _Pragma("unroll") for (int k = 0; k < 2; ++k) dst[m][k] = *(const LAS bf16x8*)(lds + PG8_SA(b, h) + aoff + m * 2048 + k * 1024); } while (0)
#define PG8_LDB(dst, b, h) do { _Pragma("unroll") for (int n = 0; n < 2; ++n) _Pragma("unroll") for (int k = 0; k < 2; ++k) dst[n][k] = *(const LAS bf16x8*)(lds + PG8_SB(b, h) + boff + n * 2048 + k * 1024); } while (0)
#define PG8_MMA(ai, bj, At, Bt) do { __builtin_amdgcn_s_setprio(1); _Pragma("unroll") for (int m = 0; m < 4; ++m) _Pragma("unroll") for (int n = 0; n < 2; ++n) _Pragma("unroll") for (int k = 0; k < 2; ++k) \
        acc[ai][bj][m][n] = __builtin_amdgcn_mfma_f32_16x16x32_bf16(Bt[n][k], At[m][k], acc[ai][bj][m][n], 0, 0, 0); __builtin_amdgcn_s_setprio(0); } while (0)
#define PG8_WAIT_V(n) asm volatile("s_waitcnt vmcnt(" #n ")" ::: "memory")
#define PG8_WAIT_L(n) asm volatile("s_waitcnt lgkmcnt(" #n ")" ::: "memory")
#define PG8_BAR __builtin_amdgcn_s_barrier()
#define PG8_SCHED __builtin_amdgcn_sched_barrier(0)
    Unit cur, nxt; int ui = 0;
    if (!S.next(0, cur)) return;
    f32x4 acc[2][2][4][2];
#pragma unroll
    for (int a = 0; a < 2; ++a)
#pragma unroll
        for (int b = 0; b < 2; ++b)
#pragma unroll
            for (int m = 0; m < 4; ++m)
#pragma unroll
                for (int n = 0; n < 2; ++n) acc[a][b][m][n] = (f32x4){0.f, 0.f, 0.f, 0.f};
    bf16x8 At[4][2], B0[2][2], B1[2][2];
    const char* cA = (const char*)g.A + (size_t)cur.pm * tstep; const char* cB = (const char*)g.Bt + (size_t)cur.pn * tstep;
    PG8_STAGE(PG8_SB(0, 0), cB, voffB); PG8_STAGE(PG8_SB(0, 1), cB + hstep, voffB); PG8_STAGE(PG8_SA(0, 0), cA, voffA); PG8_STAGE(PG8_SA(0, 1), cA + hstep, voffA);
    if (wr == 1) PG8_BAR;
    PG8_WAIT_V(2); PG8_BAR;
    PG8_STAGE(PG8_SB(1, 0), cB + kstep, voffB); PG8_STAGE(PG8_SA(1, 0), cA + kstep, voffA); PG8_STAGE(PG8_SB(1, 1), cB + hstep + kstep, voffB);
    PG8_WAIT_V(6); PG8_BAR;
    for (;;) {
        const bool has_next = S.next(ui + 1, nxt);
        const char* nA = has_next ? (const char*)g.A + (size_t)nxt.pm * tstep : cA; const char* nB = has_next ? (const char*)g.Bt + (size_t)nxt.pn * tstep : cB;
        for (int t = 0; t < nt; t += 2) {
            const bool last = (t == nt - 2);
            const char* a1 = cA + (size_t)(t + 1) * kstep;
            const char* a2 = last ? nA : cA + (size_t)(t + 2) * kstep; const char* b2 = last ? nB : cB + (size_t)(t + 2) * kstep;
            const char* a3 = a2 + kstep; const char* b3 = b2 + kstep;
            PG8_LDB(B0, 0, 0); PG8_LDB(B1, 0, 1); PG8_SCHED; PG8_LDA(At, 0, 0); PG8_STAGE(PG8_SA(1, 1), a1 + hstep, voffA);
            PG8_WAIT_V(8); PG8_WAIT_L(0); PG8_BAR; PG8_MMA(0, 0, At, B0); PG8_MMA(0, 1, At, B1); PG8_BAR; PG8_SCHED;
            PG8_LDA(At, 0, 1); PG8_STAGE(PG8_SB(0, 0), b2, voffB); PG8_STAGE(PG8_SB(0, 1), b2 + hstep, voffB); PG8_STAGE(PG8_SA(0, 0), a2, voffA);
            PG8_WAIT_V(8); PG8_WAIT_L(0); PG8_BAR; PG8_MMA(1, 0, At, B0); PG8_MMA(1, 1, At, B1); PG8_BAR; PG8_SCHED;
            PG8_LDB(B0, 1, 0); PG8_LDB(B1, 1, 1); PG8_SCHED; PG8_LDA(At, 1, 0); PG8_STAGE(PG8_SA(0, 1), a2 + hstep, voffA);
            PG8_WAIT_V(8); PG8_WAIT_L(0); PG8_BAR; PG8_MMA(0, 0, At, B0); PG8_MMA(0, 1, At, B1); PG8_BAR; PG8_SCHED;
            PG8_LDA(At, 1, 1); PG8_STAGE(PG8_SB(1, 0), b3, voffB); PG8_STAGE(PG8_SB(1, 1), b3 + hstep, voffB); PG8_STAGE(PG8_SA(1, 0), a3, voffA);
            PG8_WAIT_V(8); PG8_WAIT_L(0); PG8_BAR; PG8_MMA(1, 0, At, B0); PG8_MMA(1, 1, At, B1); PG8_BAR; PG8_SCHED;
            if constexpr (Epi::MIDK) { if (t + 2 == (nt >> 1)) E.mid(acc, cur, wr, wc, fr, fq); }
        }
        if constexpr (ALIGN_EPI) { if (wr == 0) PG8_BAR; }
        E(acc, cur, wr, wc, fr, fq);
        if (!has_next) break;
#pragma unroll
        for (int a = 0; a < 2; ++a)
#pragma unroll
            for (int b = 0; b < 2; ++b)
#pragma unroll
                for (int m = 0; m < 4; ++m)
#pragma unroll
                    for (int n = 0; n < 2; ++n) acc[a][b][m][n] = (f32x4){0.f, 0.f, 0.f, 0.f};
        cur = nxt; cA = nA; cB = nB; ++ui;
        if constexpr (ALIGN_EPI) { if (wr == 1) PG8_BAR; }
    }
    PG8_WAIT_V(0);
    if constexpr (!ALIGN_EPI) { if (wr == 0) PG8_BAR; }
    PG8_BAR;
#undef PG8_SA
#undef PG8_SB
#undef PG8_STAGE
#undef PG8_LDA
#undef PG8_LDB
#undef PG8_MMA
#undef PG8_WAIT_V
#undef PG8_WAIT_L
#undef PG8_BAR
#undef PG8_SCHED
}
}

struct Epi1 {
    static constexpr bool PERM = true, MIDK = false;
    bf16_t *QB, *KB, *VB, *HY, *GT, *XTp; const float* rstd; const float* gate_b; const f32x2* rope; int L;
    __device__ __forceinline__ void operator()(const f32x4 (&acc)[2][2][4][2], const pg8::Unit& u, int wr, int wc, int fr, int fq) const {
        const int pn = u.pn; const int row0 = u.pm * 256 + wr * 64 + fr;
#pragma unroll
        for (int ai = 0; ai < 2; ++ai)
#pragma unroll
            for (int m = 0; m < 4; ++m) {
                const int row = row0 + ai * 128 + m * 16; const float rs = rstd[row]; const int pos = row & (L - 1);
#pragma unroll
                for (int bj = 0; bj < 2; ++bj) {
                    const int lc = bj * 128 + wc * 32 + 8 * fq;
                    f32x4 v0 = acc[ai][bj][m][0] * rs, v1 = acc[ai][bj][m][1] * rs;
                    bf16_t* dst;
                    if (pn < 8) {
                        const int col = (pn & 3) * 256 + lc; const int i0 = (col & 63) >> 1;
                        const f32x2* rp = rope + (size_t)pos * 32 + i0;
                        const f32x2 c0 = rp[0], c1 = rp[1], c2 = rp[2], c3 = rp[3];
                        const float sc = (pn < 4) ? QSCALE : 1.0f;
                        f32x4 w0, w1;
                        w0[0] = (v0[0] * c0[0] - v0[1] * c0[1]) * sc; w0[1] = (v0[1] * c0[0] + v0[0] * c0[1]) * sc;
                        w0[2] = (v0[2] * c1[0] - v0[3] * c1[1]) * sc; w0[3] = (v0[3] * c1[0] + v0[2] * c1[1]) * sc;
                        w1[0] = (v1[0] * c2[0] - v1[1] * c2[1]) * sc; w1[1] = (v1[1] * c2[0] + v1[0] * c2[1]) * sc;
                        w1[2] = (v1[2] * c3[0] - v1[3] * c3[1]) * sc; w1[3] = (v1[3] * c3[0] + v1[2] * c3[1]) * sc;
                        v0 = w0; v1 = w1;
                        dst = ((pn < 4) ? QB : KB) + (size_t)row * 1024 + col;
                    } else if (pn < 12) {
                        dst = VB + (size_t)row * 1024 + (pn - 8) * 256 + lc;
                    } else if (pn < 16) {
                        dst = HY + (size_t)row * 3072 + (pn - 12) * 256 + lc;
                    } else if (pn < 24) {
                        bf16_t* xt = XTp + (size_t)((pn - 16) * 256 + lc) * CH + row;
#pragma unroll
                        for (int e = 0; e < 4; ++e) { xt[(size_t)e * CH] = (bf16_t)f2bf(v0[e]); xt[(size_t)(4 + e) * CH] = (bf16_t)f2bf(v1[e]); }
                        continue;
                    } else {
                        const int gc = (pn - 24) * 256 + lc;
                        const f32x4 b0 = *(const f32x4*)(gate_b + gc), b1 = *(const f32x4*)(gate_b + gc + 4);
#pragma unroll
                        for (int e = 0; e < 4; ++e) { v0[e] = __builtin_amdgcn_rcpf(1.0f + __expf(-(v0[e] + b0[e]))); v1[e] = __builtin_amdgcn_rcpf(1.0f + __expf(-(v1[e] + b1[e]))); }
                        dst = GT + (size_t)row * 4096 + gc;
                    }
                    u32x4 w; w.x = cvt_pk_bf16(v0[0], v0[1]); w.y = cvt_pk_bf16(v0[2], v0[3]); w.z = cvt_pk_bf16(v1[0], v1[1]); w.w = cvt_pk_bf16(v1[2], v1[3]);
                    *(u32x4*)dst = w;
                }
            }
    }
};
template <int PASS> struct Epi2 {
    static constexpr bool PERM = true, MIDK = false;
    const bf16_t* GT; bf16_t* T1; bf16_t* MG;
    __device__ __forceinline__ void operator()(const f32x4 (&acc)[2][2][4][2], const pg8::Unit& u, int wr, int wc, int fr, int fq) const {
        const int row0 = u.pm * 256 + wr * 64 + fr;
#pragma unroll
        for (int ai = 0; ai < 2; ++ai)
#pragma unroll
            for (int m = 0; m < 4; ++m) {
                const int row = row0 + ai * 128 + m * 16;
#pragma unroll
                for (int bj = 0; bj < 2; ++bj) {
                    const int col = u.pn * 256 + bj * 128 + wc * 32 + 8 * fq;
                    const u32x4 gw = *(const u32x4*)(GT + (size_t)row * 4096 + PASS * 2048 + col);
                    f32x4 v0 = acc[ai][bj][m][0], v1 = acc[ai][bj][m][1];
                    v0[0] *= bflo(gw.x); v0[1] *= bfhi(gw.x); v0[2] *= bflo(gw.y); v0[3] *= bfhi(gw.y);
                    v1[0] *= bflo(gw.z); v1[1] *= bfhi(gw.z); v1[2] *= bflo(gw.w); v1[3] *= bfhi(gw.w);
                    if (PASS == 1) {
                        const u32x4 tw = *(const u32x4*)(T1 + (size_t)row * 2048 + col);
                        v0[0] += bflo(tw.x); v0[1] += bfhi(tw.x); v0[2] += bflo(tw.y); v0[3] += bfhi(tw.y);
                        v1[0] += bflo(tw.z); v1[1] += bfhi(tw.z); v1[2] += bflo(tw.w); v1[3] += bfhi(tw.w);
                    }
                    u32x4 w; w.x = cvt_pk_bf16(v0[0], v0[1]); w.y = cvt_pk_bf16(v0[2], v0[3]); w.z = cvt_pk_bf16(v1[0], v1[1]); w.w = cvt_pk_bf16(v1[2], v1[3]);
                    *(u32x4*)((PASS == 0 ? T1 : MG) + (size_t)row * 2048 + col) = w;
                }
            }
    }
};
struct Epi2M {
    static constexpr bool PERM = true, MIDK = true;
    const bf16_t* GT; bf16_t* MG;
    __device__ __forceinline__ void mid(f32x4 (&acc)[2][2][4][2], const pg8::Unit& u, int wr, int wc, int fr, int fq) const {
        int row0 = u.pm * 256 + wr * 64 + fr; asm volatile("" : "+v"(row0));
#pragma unroll
        for (int ai = 0; ai < 2; ++ai)
#pragma unroll
            for (int m = 0; m < 4; ++m) {
                const int row = row0 + ai * 128 + m * 16;
#pragma unroll
                for (int bj = 0; bj < 2; ++bj) {
                    const int col = u.pn * 256 + bj * 128 + wc * 32 + 8 * fq;
                    const u32x4 a = *(const u32x4*)(GT + (size_t)row * 4096 + col), b = *(const u32x4*)(GT + (size_t)row * 4096 + 2048 + col);
                    acc[ai][bj][m][0][0] *= bflo(a.x) * __builtin_amdgcn_rcpf(bflo(b.x)); acc[ai][bj][m][0][1] *= bfhi(a.x) * __builtin_amdgcn_rcpf(bfhi(b.x));
                    acc[ai][bj][m][0][2] *= bflo(a.y) * __builtin_amdgcn_rcpf(bflo(b.y)); acc[ai][bj][m][0][3] *= bfhi(a.y) * __builtin_amdgcn_rcpf(bfhi(b.y));
                    acc[ai][bj][m][1][0] *= bflo(a.z) * __builtin_amdgcn_rcpf(bflo(b.z)); acc[ai][bj][m][1][1] *= bfhi(a.z) * __builtin_amdgcn_rcpf(bfhi(b.z));
                    acc[ai][bj][m][1][2] *= bflo(a.w) * __builtin_amdgcn_rcpf(bflo(b.w)); acc[ai][bj][m][1][3] *= bfhi(a.w) * __builtin_amdgcn_rcpf(bfhi(b.w));
                    __builtin_amdgcn_sched_barrier(0);
                }
            }
    }
    __device__ __forceinline__ void operator()(const f32x4 (&acc)[2][2][4][2], const pg8::Unit& u, int wr, int wc, int fr, int fq) const {
        const int row0 = u.pm * 256 + wr * 64 + fr;
#pragma unroll
        for (int ai = 0; ai < 2; ++ai)
#pragma unroll
            for (int m = 0; m < 4; ++m) {
                const int row = row0 + ai * 128 + m * 16;
#pragma unroll
                for (int bj = 0; bj < 2; ++bj) {
                    const int col = u.pn * 256 + bj * 128 + wc * 32 + 8 * fq;
                    const u32x4 gw = *(const u32x4*)(GT + (size_t)row * 4096 + 2048 + col);
                    f32x4 v0 = acc[ai][bj][m][0], v1 = acc[ai][bj][m][1];
                    v0[0] *= bflo(gw.x); v0[1] *= bfhi(gw.x); v0[2] *= bflo(gw.y); v0[3] *= bfhi(gw.y);
                    v1[0] *= bflo(gw.z); v1[1] *= bfhi(gw.z); v1[2] *= bflo(gw.w); v1[3] *= bfhi(gw.w);
                    u32x4 w; w.x = cvt_pk_bf16(v0[0], v0[1]); w.y = cvt_pk_bf16(v0[2], v0[3]); w.z = cvt_pk_bf16(v1[0], v1[1]); w.w = cvt_pk_bf16(v1[2], v1[3]);
                    *(u32x4*)(MG + (size_t)row * 2048 + col) = w;
                }
            }
    }
};
template <bool WB> struct EpiRes {
    static constexpr bool PERM = false, MIDK = false;
    const float* base; float* out; bf16_t* ob; float* part;
    __device__ __forceinline__ void operator()(const f32x4 (&acc)[2][2][4][2], const pg8::Unit& u, int wr, int wc, int fr, int fq) const {
        const int row0 = u.pm * 256 + wr * 64 + fr;
#pragma unroll
        for (int ai = 0; ai < 2; ++ai)
#pragma unroll
            for (int m = 0; m < 4; ++m) {
                const int row = row0 + ai * 128 + m * 16; float ss = 0.f;
#pragma unroll
                for (int bj = 0; bj < 2; ++bj)
#pragma unroll
                    for (int n = 0; n < 2; ++n) {
                        const size_t off = (size_t)row * 2048 + u.pn * 256 + bj * 128 + wc * 32 + n * 16 + 4 * fq;
                        const f32x4 v = *(const f32x4*)(base + off) + acc[ai][bj][m][n];
                        *(f32x4*)(out + off) = v;
                        if (WB) { u32x2 w; w.x = cvt_pk_bf16(v[0], v[1]); w.y = cvt_pk_bf16(v[2], v[3]); *(u32x2*)(ob + off) = w; }
                        ss += (v[0] * v[0] + v[1] * v[1]) + (v[2] * v[2] + v[3] * v[3]);
                    }
                { const int ln = fr + 16 * fq; ss += lane_xor_get(ss, ln, 16); ss += lane_xor_get(ss, ln, 32); }
                if (fq == 0) part[(size_t)row * 32 + u.pn * 4 + wc] = ss;
            }
    }
};
struct EpiResB {
    static constexpr bool PERM = true, MIDK = false;
    const bf16_t* base; bf16_t* ob; float* part;
    __device__ __forceinline__ void operator()(const f32x4 (&acc)[2][2][4][2], const pg8::Unit& u, int wr, int wc, int fr, int fq) const {
        const int row0 = u.pm * 256 + wr * 64 + fr;
#pragma unroll
        for (int ai = 0; ai < 2; ++ai)
#pragma unroll
            for (int m = 0; m < 4; ++m) {
                const int row = row0 + ai * 128 + m * 16; float ss = 0.f;
#pragma unroll
                for (int bj = 0; bj < 2; ++bj) {
                    const size_t off = (size_t)row * 2048 + u.pn * 256 + bj * 128 + wc * 32 + 8 * fq;
                    const u32x4 bw = *(const u32x4*)(base + off);
                    f32x4 v0 = acc[ai][bj][m][0], v1 = acc[ai][bj][m][1];
                    v0[0] += bflo(bw.x); v0[1] += bfhi(bw.x); v0[2] += bflo(bw.y); v0[3] += bfhi(bw.y);
                    v1[0] += bflo(bw.z); v1[1] += bfhi(bw.z); v1[2] += bflo(bw.w); v1[3] += bfhi(bw.w);
                    ss += ((v0[0] * v0[0] + v0[1] * v0[1]) + (v0[2] * v0[2] + v0[3] * v0[3])) + ((v1[0] * v1[0] + v1[1] * v1[1]) + (v1[2] * v1[2] + v1[3] * v1[3]));
                    u32x4 w; w.x = cvt_pk_bf16(v0[0], v0[1]); w.y = cvt_pk_bf16(v0[2], v0[3]); w.z = cvt_pk_bf16(v1[0], v1[1]); w.w = cvt_pk_bf16(v1[2], v1[3]);
                    *(u32x4*)(ob + off) = w;
                }
                { const int ln = fr + 16 * fq; ss += lane_xor_get(ss, ln, 16); ss += lane_xor_get(ss, ln, 32); }
                if (fq == 0) part[(size_t)row * 32 + u.pn * 4 + wc] = ss;
            }
    }
};
struct Epi4 {
    static constexpr bool PERM = true, MIDK = false;
    bf16_t* UP; const float* part;
    __device__ __forceinline__ void operator()(const f32x4 (&acc)[2][2][4][2], const pg8::Unit& u, int wr, int wc, int fr, int fq) const {
        const int row0 = u.pm * 256 + wr * 64 + fr;
#pragma unroll
        for (int ai = 0; ai < 2; ++ai)
#pragma unroll
            for (int m = 0; m < 4; ++m) {
                const int row = row0 + ai * 128 + m * 16;
                const f32x4 pa = *(const f32x4*)(part + (size_t)row * 32 + 8 * fq), pb = *(const f32x4*)(part + (size_t)row * 32 + 8 * fq + 4);
                float s = ((pa[0] + pa[1]) + (pa[2] + pa[3])) + ((pb[0] + pb[1]) + (pb[2] + pb[3]));
                { const int ln = fr + 16 * fq; s += lane_xor_get(s, ln, 16); s += lane_xor_get(s, ln, 32); }
                const float rs = rsqrtf(s * (1.0f / 2048.0f) + EPS);
#pragma unroll
                for (int bj = 0; bj < 2; ++bj) {
                    const int col = u.pn * 256 + bj * 128 + wc * 32 + 8 * fq;
                    const f32x4 v0 = acc[ai][bj][m][0] * rs, v1 = acc[ai][bj][m][1] * rs;
                    u32x4 w; w.x = cvt_pk_bf16(v0[0], v0[1]); w.y = cvt_pk_bf16(v0[2], v0[3]); w.z = cvt_pk_bf16(v1[0], v1[1]); w.w = cvt_pk_bf16(v1[2], v1[3]);
                    *(u32x4*)(UP + (size_t)row * UPW + col) = w;
                }
            }
    }
};

__device__ __forceinline__ void transpose_item(const float* W, int K, int N, bf16_t* WT, const float* g, bool ropeperm, LAS float* scr, int item, int lane, int ldk = 0, int koff = 0) {
    if (ldk == 0) ldk = K;
    const int nblk = N / 64, kb = item / nblk, nb = item % nblk, k0 = 64 * kb, n0 = 64 * nb;
    int sn = n0 + lane;
    if (ropeperm && sn < 2048) sn = (sn & ~63) + ((sn & 63) >> 1) + 32 * (sn & 1);
    float wv[64];
#pragma unroll
    for (int kk = 0; kk < 64; ++kk) wv[kk] = __builtin_nontemporal_load(W + (size_t)(k0 + kk) * N + sn);
    if (g) {
#pragma unroll
        for (int kk = 0; kk < 64; kk += 4) { const f32x4 gg = *(const f32x4*)(g + k0 + kk); wv[kk] *= gg[0]; wv[kk + 1] *= gg[1]; wv[kk + 2] *= gg[2]; wv[kk + 3] *= gg[3]; }
    }
#pragma unroll
    for (int kk = 0; kk < 64; ++kk) scr[kk * 65 + lane] = wv[kk];
    asm volatile("s_waitcnt lgkmcnt(0)" ::: "memory");
    const int c = lane & 7;
#pragma unroll
    for (int j = 0; j < 8; ++j) { const int n = (lane >> 3) + 8 * j; const LAS float* s = scr + (8 * c) * 65 + n;
        u32x4 o; o.x = pk2(s[0 * 65], s[1 * 65]); o.y = pk2(s[2 * 65], s[3 * 65]); o.z = pk2(s[4 * 65], s[5 * 65]); o.w = pk2(s[6 * 65], s[7 * 65]);
        *(u32x4*)(WT + (size_t)(n0 + n) * ldk + koff + k0 + 8 * c) = o; }
    asm volatile("s_waitcnt lgkmcnt(0)" ::: "memory");
}

constexpr int AT_KB = 64 * 272, AT_VB = 64 * 320, AT_BUF = AT_KB + AT_VB;
__device__ __forceinline__ void attn_stage(LAS unsigned char* lds, int bufoff, const bf16_t* Kg, const bf16_t* Vg, int wid, int lane) {
#pragma unroll
    for (int i = 0; i < 5; ++i) {
        const int pc = wid + 8 * i;
        if (pc < 37) {
            const bool isk = pc < 17; const int o = (isk ? pc : pc - 17) * 1024 + lane * 16;
            const int pitch = isk ? 272 : 320; const int row = o / pitch; int ch = (o - row * pitch) >> 4; if (ch > 15) ch = 0;
            const bf16_t* src = (isk ? Kg : Vg) + (unsigned)(row * 1024 + ch * 8);
            __builtin_amdgcn_global_load_lds((const unsigned*)src, (LAS unsigned*)(lds + bufoff + (isk ? 0 : AT_KB) + (isk ? pc : pc - 17) * 1024), 16, 0, 0);
        }
    }
}
__device__ __forceinline__ s16x4 vtr(const LAS unsigned char* p) { typedef short v4i16_t __attribute__((ext_vector_type(4))); return __builtin_bit_cast(s16x4, __builtin_amdgcn_ds_read_tr16_b64_v4i16((LAS v4i16_t*)p)); }

__device__ __forceinline__ void softmax_step(f32x16& s, float& m, float& l, f32x16 (&o)[4], bf16x8 (&pk)[2]) {
    float a = fmaxf(fmaxf(s[0], s[1]), s[2]), b = fmaxf(fmaxf(s[3], s[4]), s[5]);
    a = fmaxf(fmaxf(a, s[6]), s[7]); b = fmaxf(fmaxf(b, s[8]), s[9]);
    a = fmaxf(fmaxf(a, s[10]), s[11]); b = fmaxf(fmaxf(b, s[12]), s[13]);
    a = fmaxf(fmaxf(a, s[14]), s[15]);
    const float mx = swap_max(fmaxf(a, b));
    if (__any(mx > m + 8.0f)) {
        const float mn = fmaxf(m, mx);
        const float alpha = __builtin_amdgcn_exp2f(m - mn);
#pragma unroll
        for (int d = 0; d < 4; ++d)
#pragma unroll
            for (int r = 0; r < 16; ++r) o[d][r] *= alpha;
        l *= alpha; m = mn;
    }
    float sum = 0.f;
#pragma unroll
    for (int r = 0; r < 16; ++r) { s[r] = __builtin_amdgcn_exp2f(s[r] - m); sum += s[r]; }
    l += sum;
#pragma unroll
    for (int ks = 0; ks < 2; ++ks) {
        u32x4 w; w.x = cvt_pk_bf16(s[8 * ks + 0], s[8 * ks + 1]); w.y = cvt_pk_bf16(s[8 * ks + 2], s[8 * ks + 3]); w.z = cvt_pk_bf16(s[8 * ks + 4], s[8 * ks + 5]); w.w = cvt_pk_bf16(s[8 * ks + 6], s[8 * ks + 7]);
        pk[ks] = __builtin_bit_cast(bf16x8, w);
    }
}

__device__ __forceinline__ void softmax_step64(f32x16& sa, f32x16& sb, float& m, float& l, f32x16 (&o)[4], bf16x8 (&pk)[4]) {
    float a = fmaxf(fmaxf(sa[0], sa[1]), sa[2]), b = fmaxf(fmaxf(sb[0], sb[1]), sb[2]);
#pragma unroll
    for (int r = 3; r < 15; r += 2) { a = fmaxf(fmaxf(a, sa[r]), sa[r + 1]); b = fmaxf(fmaxf(b, sb[r]), sb[r + 1]); }
    a = fmaxf(a, sa[15]); b = fmaxf(b, sb[15]);
    const float mx = swap_max(fmaxf(a, b));
    if (__any(mx > m + 8.0f)) {
        const float mn = fmaxf(m, mx);
        const float alpha = __builtin_amdgcn_exp2f(m - mn);
#pragma unroll
        for (int d = 0; d < 4; ++d)
#pragma unroll
            for (int r = 0; r < 16; ++r) o[d][r] *= alpha;
        l *= alpha; m = mn;
    }
    float sum = 0.f;
#pragma unroll
    for (int r = 0; r < 16; ++r) { sa[r] = __builtin_amdgcn_exp2f(sa[r] - m); sb[r] = __builtin_amdgcn_exp2f(sb[r] - m); sum += sa[r] + sb[r]; }
    l += sum;
#pragma unroll
    for (int ks = 0; ks < 2; ++ks) {
        u32x4 w; w.x = cvt_pk_bf16(sa[8 * ks + 0], sa[8 * ks + 1]); w.y = cvt_pk_bf16(sa[8 * ks + 2], sa[8 * ks + 3]); w.z = cvt_pk_bf16(sa[8 * ks + 4], sa[8 * ks + 5]); w.w = cvt_pk_bf16(sa[8 * ks + 6], sa[8 * ks + 7]);
        pk[ks] = __builtin_bit_cast(bf16x8, w);
        u32x4 v; v.x = cvt_pk_bf16(sb[8 * ks + 0], sb[8 * ks + 1]); v.y = cvt_pk_bf16(sb[8 * ks + 2], sb[8 * ks + 3]); v.z = cvt_pk_bf16(sb[8 * ks + 4], sb[8 * ks + 5]); v.w = cvt_pk_bf16(sb[8 * ks + 6], sb[8 * ks + 7]);
        pk[2 + ks] = __builtin_bit_cast(bf16x8, v);
    }
}
__device__ __forceinline__ void attn_item(LAS unsigned char* lds, const bf16_t* QB, const bf16_t* KB, const bf16_t* VB, bf16_t* AT, int tb, int h, int qb, int L, float lam, const float* subln) {
    int tid = threadIdx.x; asm volatile("" : "+v"(tid));
    const int lane = tid & 63, r32 = lane & 31, hi = lane >> 5; const int wid = __builtin_amdgcn_readfirstlane(tid >> 6);
    const int tokq = tb + qb * 256 + wid * 32 + r32;
    LAS unsigned char* qs = lds + 2 * AT_BUF + wid * 8704 + r32 * 272 + hi * 16;
#pragma unroll
    for (int mp = 0; mp < 2; ++mp)
#pragma unroll
        for (int d0 = 0; d0 < 4; ++d0) *(LAS bf16x8*)(qs + mp * 128 + d0 * 32) = *(const bf16x8*)(QB + (size_t)tokq * 1024 + h * 128 + mp * 64 + d0 * 16 + hi * 8);
    f32x16 o0[4], o1[4];
#pragma unroll
    for (int d = 0; d < 4; ++d)
#pragma unroll
        for (int r = 0; r < 16; ++r) { o0[d][r] = 0.f; o1[d][r] = 0.f; }
    float m0 = -INFINITY, m1 = -INFINITY, l0 = 0.f, l1 = 0.f;
    const bf16_t* Kh = KB + (size_t)tb * 1024 + h * 128; const bf16_t* Vh = VB + (size_t)tb * 1024 + h * 128;
    const int NT = L / 64;
    const int qd = (lane & 15) >> 2, pp = lane & 3, blk = (lane >> 4) & 1;
    const int koff = r32 * 272 + hi * 16;
    const int voff = AT_KB + (4 * hi + qd) * 320 + (16 * blk + 4 * pp) * 2;
    bf16x8 pk0[4], pk1[4];
#define AT_S64(cbuf, MP, MM, LL, OO, PK) do { \
        const LAS unsigned char* kp = lds + (cbuf) + koff + (MP) * 128; \
        bf16x8 qa[4], ka[4], kb[4]; \
        f32x16 sa, sb; _Pragma("unroll") for (int r = 0; r < 16; ++r) { sa[r] = 0.f; sb[r] = 0.f; } \
        _Pragma("unroll") for (int d0 = 0; d0 < 2; ++d0) { qa[d0] = *(const LAS bf16x8*)(qs + (MP) * 128 + d0 * 32); ka[d0] = *(const LAS bf16x8*)(kp + d0 * 32); kb[d0] = *(const LAS bf16x8*)(kp + 32 * 272 + d0 * 32); } \
        __builtin_amdgcn_sched_barrier(0); \
        _Pragma("unroll") for (int d0 = 0; d0 < 2; ++d0) { \
            sa = __builtin_amdgcn_mfma_f32_32x32x16_bf16(ka[d0], qa[d0], sa, 0, 0, 0); \
            sb = __builtin_amdgcn_mfma_f32_32x32x16_bf16(kb[d0], qa[d0], sb, 0, 0, 0); } \
        _Pragma("unroll") for (int d0 = 2; d0 < 4; ++d0) { qa[d0] = *(const LAS bf16x8*)(qs + (MP) * 128 + d0 * 32); ka[d0] = *(const LAS bf16x8*)(kp + d0 * 32); kb[d0] = *(const LAS bf16x8*)(kp + 32 * 272 + d0 * 32); } \
        __builtin_amdgcn_sched_barrier(0); \
        _Pragma("unroll") for (int d0 = 2; d0 < 4; ++d0) { \
            sa = __builtin_amdgcn_mfma_f32_32x32x16_bf16(ka[d0], qa[d0], sa, 0, 0, 0); \
            sb = __builtin_amdgcn_mfma_f32_32x32x16_bf16(kb[d0], qa[d0], sb, 0, 0, 0); } \
        __builtin_amdgcn_sched_barrier(0); \
        softmax_step64(sa, sb, MM, LL, OO, PK); \
        __builtin_amdgcn_sched_barrier(0); } while (0)
#define AT_PV64(cbuf, sub) do { \
        const LAS unsigned char* vp = lds + (cbuf) + voff + (sub) * 32 * 320; \
        _Pragma("unroll") for (int hh = 0; hh < 2; ++hh) { \
            s16x4 vlo[4], vhi[4]; \
            _Pragma("unroll") for (int i2 = 0; i2 < 4; ++i2) { const int i = 4 * hh + i2; vlo[i2] = vtr(vp + (i & 1) * 16 * 320 + (i >> 1) * 64); vhi[i2] = vtr(vp + (i & 1) * 16 * 320 + 8 * 320 + (i >> 1) * 64); } \
            __builtin_amdgcn_sched_barrier(0); \
            _Pragma("unroll") for (int i2 = 0; i2 < 4; ++i2) { const int i = 4 * hh + i2; \
                const bf16x8 vf = (bf16x8){vlo[i2][0], vlo[i2][1], vlo[i2][2], vlo[i2][3], vhi[i2][0], vhi[i2][1], vhi[i2][2], vhi[i2][3]}; \
                o0[i >> 1] = __builtin_amdgcn_mfma_f32_32x32x16_bf16(vf, pk0[2 * (sub) + (i & 1)], o0[i >> 1], 0, 0, 0); \
                o1[i >> 1] = __builtin_amdgcn_mfma_f32_32x32x16_bf16(vf, pk1[2 * (sub) + (i & 1)], o1[i >> 1], 0, 0, 0); } \
            __builtin_amdgcn_sched_barrier(0); } } while (0)
    attn_stage(lds, 0, Kh, Vh, wid, lane);
    asm volatile("s_waitcnt vmcnt(0)" ::: "memory"); __syncthreads();
    for (int t = 0; t < NT; ++t) {
        const int cb = (t & 1) * AT_BUF;
        if (t + 1 < NT) attn_stage(lds, AT_BUF - cb, Kh + (size_t)(t + 1) * 64 * 1024, Vh + (size_t)(t + 1) * 64 * 1024, wid, lane);
        AT_S64(cb, 0, m0, l0, o0, pk0);
        AT_S64(cb, 1, m1, l1, o1, pk1);
        AT_PV64(cb, 0);
        AT_PV64(cb, 1);
        asm volatile("s_waitcnt vmcnt(0)" ::: "memory"); __syncthreads();
    }
#undef AT_S64
#undef AT_PV64
    int tq2 = tb + qb * 256 + wid * 32 + r32; asm volatile("" : "+v"(tq2));
    l0 = swap_add(l0); l1 = swap_add(l1);
    const float i0 = 1.0f / l0, i1 = __uint_as_float((unsigned)__builtin_amdgcn_readfirstlane((int)__float_as_uint(lam))) / l1;
    float ss = 0.f;
#pragma unroll
    for (int d = 0; d < 4; ++d)
#pragma unroll
        for (int r = 0; r < 16; ++r) { const float a = o0[d][r] * i0 - o1[d][r] * i1; o0[d][r] = a; ss += a * a; }
    ss = swap_add(ss);
    const float rs = rsqrtf(ss * (1.0f / 128.0f) + EPS) * (1.0f - LAMBDA_INIT);
    bf16_t* orow = AT + (size_t)tq2 * 2048 + h * 128;
#pragma unroll
    for (int d = 0; d < 4; ++d)
#pragma unroll
        for (int g = 0; g < 4; ++g) {
            const int dd = 32 * d + 8 * g + 4 * hi;
            const f32x4 gg = *(const f32x4*)(subln + dd);
            u32x2 w; w.x = cvt_pk_bf16(o0[d][4 * g + 0] * rs * gg[0], o0[d][4 * g + 1] * rs * gg[1]); w.y = cvt_pk_bf16(o0[d][4 * g + 2] * rs * gg[2], o0[d][4 * g + 3] * rs * gg[3]);
            *(u32x2*)(orow + dd) = w;
        }
}

constexpr int HY_F1 = 32832, HY_U = 66048;
__device__ __forceinline__ void hyena_item(LAS unsigned char* lds, const bf16_t* FILT  , const bf16_t* XTp, const float* cw, const float* cb, bf16_t* YT, int c, int L) {
    int tid = threadIdx.x; asm volatile("" : "+v"(tid));
    const int lane = tid & 63, r32 = lane & 31, hi = lane >> 5; const int wid = __builtin_amdgcn_readfirstlane(tid >> 6);
    const int NB = L >> 5, B = CH / L, G = 32 / B, gsh = (B == 2) ? 4 : 3, APAD = 4 * G, NBP = NB + 8 * G + 4, QP = NBP >> 2, BS = 16 * QP + 8;
    __syncthreads();
    {
        const int npc = (2 * L * 2) / 16;
        const u32x4* src = (const u32x4*)(FILT + (size_t)c * 4 * L);
        for (int q = tid; q < 2 * npc; q += 512) {
            const int cp = q >= npc; const int qq = cp ? q - npc : q;
            *(LAS u32x4*)(lds + (cp ? HY_F1 : 0) + qq * 16) = src[q];
        }
        const bf16_t* x1t = XTp + (size_t)c * CH; const bf16_t* hvt = XTp + (size_t)(1024 + c) * CH;
        const float wx0 = cw[1024 + c], wx1 = cw[3072 + 1024 + c], wx2 = cw[6144 + 1024 + c], bx = cb[1024 + c];
        const float wh0 = cw[2048 + c], wh1 = cw[3072 + 2048 + c], wh2 = cw[6144 + 2048 + c], bh = cb[2048 + c];
        for (int q = tid; q < CH / 8; q += 512) {
            const int tk = q * 8, b = tk / L, pos = tk - b * L, a = pos >> 5, r = (pos >> 3) & 3;
            const u32x4 xw = __builtin_nontemporal_load((const u32x4*)(x1t + tk)), hw = __builtin_nontemporal_load((const u32x4*)(hvt + tk));
            const float px = pos > 0 ? bf2f(x1t[tk - 1]) : 0.f, ph = pos > 0 ? bf2f(hvt[tk - 1]) : 0.f;
            const float nx = pos + 8 < L ? bf2f(x1t[tk + 8]) : 0.f, nh = pos + 8 < L ? bf2f(hvt[tk + 8]) : 0.f;
            float xs[10], hs[10];
            xs[0] = px; xs[1] = bflo(xw.x); xs[2] = bfhi(xw.x); xs[3] = bflo(xw.y); xs[4] = bfhi(xw.y); xs[5] = bflo(xw.z); xs[6] = bfhi(xw.z); xs[7] = bflo(xw.w); xs[8] = bfhi(xw.w); xs[9] = nx;
            hs[0] = ph; hs[1] = bflo(hw.x); hs[2] = bfhi(hw.x); hs[3] = bflo(hw.y); hs[4] = bfhi(hw.y); hs[5] = bflo(hw.z); hs[6] = bfhi(hw.z); hs[7] = bflo(hw.w); hs[8] = bfhi(hw.w); hs[9] = nh;
            float u[8];
#pragma unroll
            for (int e = 0; e < 8; ++e) u[e] = (wx0 * xs[e] + wx1 * xs[e + 1] + wx2 * xs[e + 2] + bx) * (wh0 * hs[e] + wh1 * hs[e + 1] + wh2 * hs[e + 2] + bh);
            u32x4 uw; uw.x = cvt_pk_bf16(u[0], u[1]); uw.y = cvt_pk_bf16(u[2], u[3]); uw.z = cvt_pk_bf16(u[4], u[5]); uw.w = cvt_pk_bf16(u[6], u[7]);
            { const int idx = APAD + a; *(LAS u32x4*)(lds + HY_U + (b * BS + (r * 4 + (idx & 3)) * QP + (idx >> 2)) * 16) = uw; }
        }
        const int npad = 8 * G + 4, nz = 4 * B * npad;
        for (int z = tid; z < nz; z += 512) {
            const int plane = z / npad, w_ = z - plane * npad; const int idx = (w_ < APAD) ? w_ : NB + w_;
            *(LAS u32x4*)(lds + HY_U + ((plane >> 2) * BS + ((plane & 3) * 4 + (idx & 3)) * QP + (idx >> 2)) * 16) = zero4();
        }
    }
    __syncthreads();
    {
    const int wq = wid & 3, half = wid >> 2;
    f32x16 acc0, acc1, acc2, acc3;
#pragma unroll
    for (int r = 0; r < 16; ++r) { acc0[r] = 0.f; acc1[r] = 0.f; acc2[r] = 0.f; acc3[r] = 0.f; }
    const int bn = r32 >> gsh, iblk = r32 & (G - 1);
    const int Ib = G * 4 * wq;
    const int dlo_all = Ib - NB + 1, dhi_all = Ib + 4 * G - 1, dmid = dlo_all + ((dhi_all - dlo_all + 1) >> 1);
    const int dlo = half ? dmid : dlo_all, dhi = half ? dhi_all : dmid - 1;
#define HY_LOADA(P, DL) do { \
        _Pragma("unroll") for (int kh = 0; kh < 2; ++kh) { \
            const int x0 = L - 32 * (DL) + 16 * kh + 8 * hi - r32; const int cp = x0 & 1; const int xe = x0 - cp; \
            const LAS unsigned* fp = (const LAS unsigned*)(lds + (cp ? HY_F1 : 0)) + (xe >> 1); \
            P##a[kh].x = fp[0]; P##a[kh].y = fp[1]; P##a[kh].z = fp[2]; P##a[kh].w = fp[3]; } } while (0)
#define HY_LOADB(P, DL) do { \
        const int ix = Ib + APAD - (DL); \
        _Pragma("unroll") for (int kh = 0; kh < 2; ++kh) \
            P##b[kh] = *(const LAS u32x4*)(lds + HY_U + (bn * BS + ((2 * kh + hi) * 4 + (ix & 3)) * QP + (ix >> 2) + iblk) * 16); } while (0)
#define HY_CL(x) ((x) <= dhi ? (x) : dhi)
#define HY_LD(P, DL) do { const int d_ = HY_CL(DL); HY_LOADA(P, d_); HY_LOADB(P, d_); } while (0)
#define HY_MMA4(P, Q1, Q2, Q3) do { \
        _Pragma("unroll") for (int kh = 0; kh < 2; ++kh) { \
            acc0 = __builtin_amdgcn_mfma_f32_32x32x16_bf16(__builtin_bit_cast(bf16x8, P##a[kh]), __builtin_bit_cast(bf16x8, P##b[kh]), acc0, 0, 0, 0); \
            acc1 = __builtin_amdgcn_mfma_f32_32x32x16_bf16(__builtin_bit_cast(bf16x8, P##a[kh]), __builtin_bit_cast(bf16x8, Q1##b[kh]), acc1, 0, 0, 0); \
            acc2 = __builtin_amdgcn_mfma_f32_32x32x16_bf16(__builtin_bit_cast(bf16x8, P##a[kh]), __builtin_bit_cast(bf16x8, Q2##b[kh]), acc2, 0, 0, 0); \
            acc3 = __builtin_amdgcn_mfma_f32_32x32x16_bf16(__builtin_bit_cast(bf16x8, P##a[kh]), __builtin_bit_cast(bf16x8, Q3##b[kh]), acc3, 0, 0, 0); } } while (0)
#define HY_SB() __builtin_amdgcn_sched_barrier(0)
    u32x4 P0a[2], P0b[2], P1a[2], P1b[2], P2a[2], P2b[2], P3a[2], P3b[2], P4a[2], P4b[2];
    HY_LOADB(P4, dlo - 1); HY_LOADB(P3, dlo - 2); HY_LOADB(P2, dlo - 3);
    HY_LD(P0, dlo);
    int dl = dlo;
    for (; dl + 4 <= dhi; dl += 5) {
        HY_SB(); HY_LD(P1, dl + 1); HY_SB(); HY_MMA4(P0, P4, P3, P2);
        HY_SB(); HY_LD(P2, dl + 2); HY_SB(); HY_MMA4(P1, P0, P4, P3);
        HY_SB(); HY_LD(P3, dl + 3); HY_SB(); HY_MMA4(P2, P1, P0, P4);
        HY_SB(); HY_LD(P4, dl + 4); HY_SB(); HY_MMA4(P3, P2, P1, P0);
        HY_SB(); HY_LD(P0, dl + 5); HY_SB(); HY_MMA4(P4, P3, P2, P1);
    }
    HY_SB();
    if (dl <= dhi)     { HY_LD(P1, dl + 1); HY_MMA4(P0, P4, P3, P2); }
    if (dl + 1 <= dhi) { HY_LD(P2, dl + 2); HY_MMA4(P1, P0, P4, P3); }
    if (dl + 2 <= dhi) { HY_LD(P3, dl + 3); HY_MMA4(P2, P1, P0, P4); }
    if (dl + 3 <= dhi) { HY_MMA4(P3, P2, P1, P0); }
#undef HY_LOADA
#undef HY_LOADB
#undef HY_CL
#undef HY_LD
#undef HY_MMA4
#undef HY_SB
    __syncthreads();
    LAS float* stash = (LAS float*)lds + (wq * 64) * 64 + lane;
    if (half) {
#pragma unroll
        for (int r = 0; r < 16; ++r) { stash[(r) * 64] = acc0[r]; stash[(16 + r) * 64] = acc1[r]; stash[(32 + r) * 64] = acc2[r]; stash[(48 + r) * 64] = acc3[r]; }
    }
    __syncthreads();
    if (!half) {
#pragma unroll
        for (int r = 0; r < 16; ++r) { acc0[r] += stash[(r) * 64]; acc1[r] += stash[(16 + r) * 64]; acc2[r] += stash[(32 + r) * 64]; acc3[r] += stash[(48 + r) * 64]; }
        bf16_t* yb = YT + (size_t)c * CH + bn * L + 32 * (Ib + 4 * iblk) + 4 * hi;
#pragma unroll
        for (int g = 0; g < 4; ++g) {
            u32x2 w;
            w.x = cvt_pk_bf16(acc0[4 * g + 0], acc0[4 * g + 1]); w.y = cvt_pk_bf16(acc0[4 * g + 2], acc0[4 * g + 3]); *(u32x2*)(yb + 8 * g) = w;
            w.x = cvt_pk_bf16(acc1[4 * g + 0], acc1[4 * g + 1]); w.y = cvt_pk_bf16(acc1[4 * g + 2], acc1[4 * g + 3]); *(u32x2*)(yb + 32 + 8 * g) = w;
            w.x = cvt_pk_bf16(acc2[4 * g + 0], acc2[4 * g + 1]); w.y = cvt_pk_bf16(acc2[4 * g + 2], acc2[4 * g + 3]); *(u32x2*)(yb + 64 + 8 * g) = w;
            w.x = cvt_pk_bf16(acc3[4 * g + 0], acc3[4 * g + 1]); w.y = cvt_pk_bf16(acc3[4 * g + 2], acc3[4 * g + 3]); *(u32x2*)(yb + 96 + 8 * g) = w;
        }
    }
    }
}

__device__ __forceinline__ void conv8(const bf16_t* src, int pitch, bool hasp, bool hasn, const float* w, int C, const float* b, float (&o)[8]) {
    const u32x4 z = zero4();
    const u32x4 cu = *(const u32x4*)src; const u32x4 pv = hasp ? *(const u32x4*)(src - pitch) : z; const u32x4 nx = hasn ? *(const u32x4*)(src + pitch) : z;
    const f32x4 w0a = *(const f32x4*)(w), w0b = *(const f32x4*)(w + 4), w1a = *(const f32x4*)(w + C), w1b = *(const f32x4*)(w + C + 4), w2a = *(const f32x4*)(w + 2 * C), w2b = *(const f32x4*)(w + 2 * C + 4);
    const f32x4 ba = *(const f32x4*)b, bb = *(const f32x4*)(b + 4);
    o[0] = w0a[0] * bflo(pv.x) + w1a[0] * bflo(cu.x) + w2a[0] * bflo(nx.x) + ba[0];
    o[1] = w0a[1] * bfhi(pv.x) + w1a[1] * bfhi(cu.x) + w2a[1] * bfhi(nx.x) + ba[1];
    o[2] = w0a[2] * bflo(pv.y) + w1a[2] * bflo(cu.y) + w2a[2] * bflo(nx.y) + ba[2];
    o[3] = w0a[3] * bfhi(pv.y) + w1a[3] * bfhi(cu.y) + w2a[3] * bfhi(nx.y) + ba[3];
    o[4] = w0b[0] * bflo(pv.z) + w1b[0] * bflo(cu.z) + w2b[0] * bflo(nx.z) + bb[0];
    o[5] = w0b[1] * bfhi(pv.z) + w1b[1] * bfhi(cu.z) + w2b[1] * bfhi(nx.z) + bb[1];
    o[6] = w0b[2] * bflo(pv.w) + w1b[2] * bflo(cu.w) + w2b[2] * bflo(nx.w) + bb[2];
    o[7] = w0b[3] * bfhi(pv.w) + w1b[3] * bfhi(cu.w) + w2b[3] * bfhi(nx.w) + bb[3];
}


#define XB_TMO      128
#define XB_XCNT(j)  (256  + 64 * (j))
#define XB_XSUB(j)  (1280 + 64 * (j))
#define XB_XGEN(j)  (2304 + 64 * (j))
#define XB_TOP      3328
#define XB_TOPGEN   3392
#define XCD_BAR_WORDS 3456
#define XB_SPIN_CAP (1u << 18)
__device__ __forceinline__ unsigned xb_ld(unsigned* p)              { return __hip_atomic_load(p, __ATOMIC_RELAXED, __HIP_MEMORY_SCOPE_AGENT); }
__device__ __forceinline__ unsigned xb_add(unsigned* p, unsigned v) { return __hip_atomic_fetch_add(p, v, __ATOMIC_RELAXED, __HIP_MEMORY_SCOPE_AGENT); }
__device__ __forceinline__ unsigned xb_xcc_id() { return (unsigned)__builtin_amdgcn_s_getreg((3 << 11) | 20) & 0xFu; }
#define XB_SPIN(cond, bar) do { unsigned _sp = 0; while (cond) { __builtin_amdgcn_s_sleep(1); \
    if ((++_sp & 255u) == 0u) { if (xb_ld(&(bar)[XB_TMO])) break; if (_sp > XB_SPIN_CAP) { atomicAdd(&(bar)[XB_TMO], 1u); break; } } } } while (0)
__device__ __forceinline__ void xcd_barrier_complete(unsigned* bar, unsigned x, unsigned& nloc, unsigned& nx) {
    const unsigned G = gridDim.x * gridDim.y * gridDim.z;
    unsigned sum, cnt, mine, sp = 0u;
    for (;;) {
        sum = 0u; cnt = 0u; mine = 0u;
#pragma unroll
        for (unsigned j = 0; j < 16; ++j) { const unsigned c = xb_ld(&bar[XB_XCNT(j)]); sum += c; cnt += (c > 0u) ? 1u : 0u; mine = (j == x) ? c : mine; }
        if (sum == G) break;
        __builtin_amdgcn_s_sleep(1);
        if ((++sp & 255u) == 0u) { if (xb_ld(&bar[XB_TMO])) break; if (sp > XB_SPIN_CAP) { atomicAdd(&bar[XB_TMO], 1u); break; } }
    }
    nloc = mine > 0u ? mine : 1u; nx = cnt > 0u ? cnt : 1u;
}
__device__ __forceinline__ void xcd_barrier(unsigned* bar, volatile LAS unsigned* st) {
    asm volatile("s_waitcnt vmcnt(0)" ::: "memory");
    __syncthreads();
    if (threadIdx.x == 0) {
        const unsigned x = xb_xcc_id();
        __builtin_amdgcn_s_waitcnt(0);
        unsigned nloc = st[0], nx = st[1];
        if (nloc == 0u) { xcd_barrier_complete(bar, x, nloc, nx); st[0] = nloc; st[1] = nx; }
        const unsigned old = xb_add(&bar[XB_XSUB(x)], 1u);
        const unsigned gen = old / nloc;
        if (old + 1u == (gen + 1u) * nloc) {
            __builtin_amdgcn_fence(__ATOMIC_RELEASE, "agent");
            asm volatile("s_waitcnt vmcnt(0)" ::: "memory");
            const unsigned og = xb_add(&bar[XB_TOP], 1u);
            const unsigned tg = og / nx;
            if (og + 1u == (tg + 1u) * nx) xb_add(&bar[XB_TOPGEN], 1u);
            else XB_SPIN(xb_ld(&bar[XB_TOPGEN]) == tg, bar);
            __builtin_amdgcn_fence(__ATOMIC_ACQUIRE, "agent");
            xb_add(&bar[XB_XGEN(x)], 1u);
            asm volatile("s_waitcnt vmcnt(0)" ::: "memory");
        } else {
            XB_SPIN(xb_ld(&bar[XB_XGEN(x)]) == gen, bar);
            __builtin_amdgcn_fence(__ATOMIC_ACQUIRE, "agent");
            asm volatile("s_waitcnt vmcnt(0)" ::: "memory");
        }
    }
    __syncthreads();
}

#ifndef PHMASK
#define PHMASK 0xFFFFu
#endif
#ifndef REPMASK
#define REPMASK 0u
#endif
#define MISC_OFF 147392
#define GSYNC() do { kparams_t KPb = kparams(); xcd_barrier((unsigned*)(KPb->ws + WS_CTL), (volatile LAS unsigned*)(lds + MISC_OFF)); } while (0)
#define REPS(k) for (int rep_ = 0; rep_ < 1 + (int)((REPMASK >> (k)) & 1u); ++rep_)
constexpr int LDS_BYTES = 147456;
typedef const __attribute__((address_space(4))) Params* kparams_t;
__device__ __forceinline__ kparams_t kparams() { kparams_t p = (kparams_t)__builtin_amdgcn_kernarg_segment_ptr(); asm volatile("" : "+s"(p)); return p; }
#define PIN(i) ((const float*)KP->in[i])
__device__ __forceinline__ const float* xin_ptr(kparams_t KP, int chunk) { int c = chunk; asm volatile("" : "+s"(c)); return c == 0 ? (const float*)KP->in[0] : (const float*)KP->in[1] + ((size_t)(c - 1) << 25); }
__device__ __forceinline__ float* outc_ptr(kparams_t KP, int chunk) { int c = chunk; asm volatile("" : "+s"(c)); return (float*)KP->out + ((size_t)c << 25); }
#define WSB(off) ((bf16_t*)(ws + (off)))
#define WSF(off) ((float*)(ws + (off)))
#define PHASE_BEGIN kparams_t KP = kparams(); unsigned char* ws = KP->ws; (void)ws; int tid = threadIdx.x; asm volatile("" : "+v"(tid)); const int lane = tid & 63; const int wid = __builtin_amdgcn_readfirstlane(tid >> 6); const int gw = bid * 8 + wid; (void)lane; (void)gw;
#define PART1 WSF(WS_PART1)
#define PART2 WSF(WS_PART2)
#define RSTD1 WSF(WS_RSTD1)
#define ROPE ((f32x2*)(ws + WS_ROPE))
#define H3 WSF(WS_H3)
#define WIN WSB(WS_WIN)
#define WUP WSB(WS_WUP)
#define WDN WSB(WS_WDN)
#define WOUT WSB(WS_WOUT)
#define WA WSB(WS_WA)
#define WH WSB(WS_WH)
#define F4 WSB(WS_F4)
#define F8 WSB(WS_F8)
#define XB WSB(WS_XB)
#define MG WSB(WS_R23)
#define X1B WSB(WS_R1 + R1_UT)
#define X2B WSB(WS_R1 + R1_UT)
#define ACT WSB(WS_R23)
#define QB WSB(WS_R1 + R1_QB)
#define KB WSB(WS_R1 + R1_KB)
#define VB WSB(WS_R1 + R1_VB)
#define HY WSB(WS_R1 + R1_HY)
#define GT WSB(WS_R1 + R1_GT)
#define AT WSB(WS_R1 + R1_AT)
#define HN WSB(WS_R1 + R1_HN)
#define UT WSB(WS_R1 + R1_UT)
#define YT WSB(WS_R1 + R1_YT)
#define XT WSB(WS_R1 + R1_XT)
#define T1 WSB(WS_R1 + R1_QB)
#define UP WSB(WS_R1 + R1_QB)
#define BODY_PA(CK) do { const float* xin_ = xin_ptr(KP, (CK)); \
        for (int row = gw; row < CH; row += NGW) { \
            const f32x4* xr = (const f32x4*)(xin_ + (size_t)row * DM) + lane; \
            f32x4 v[8]; float s = 0.f; \
            _Pragma("unroll") for (int j = 0; j < 8; ++j) { v[j] = __builtin_nontemporal_load(xr + 64 * j); s += (v[j][0] * v[j][0] + v[j][1] * v[j][1]) + (v[j][2] * v[j][2] + v[j][3] * v[j][3]); } \
            s = wave_sum(s, lane); \
            if (lane == 0) RSTD1[row] = rsqrtf(s * (1.0f / DM) + EPS); \
            u32x2* o = (u32x2*)(XB + (size_t)row * DM) + lane; \
            _Pragma("unroll") for (int j = 0; j < 8; ++j) { u32x2 w; w.x = cvt_pk_bf16(v[j][0], v[j][1]); w.y = cvt_pk_bf16(v[j][2], v[j][3]); o[64 * j] = w; } \
        } } while (0)
#define BODY_FINAL(CK) do { const float* nf = PIN(29); float* outc_ = outc_ptr(KP, (CK)); \
        for (int row = gw; row < CH; row += NGW) { \
            float s = (lane < 32) ? PART2[(size_t)row * 32 + lane] : 0.f; \
            s = wave_sum(s, lane); \
            const float rs = rsqrtf(s * (1.0f / DM) + EPS); \
            const u32x4* xr = (const u32x4*)(X2B + (size_t)row * DM) + lane; f32x4* orow = (f32x4*)(outc_ + (size_t)row * DM); const f32x4* gr = (const f32x4*)nf; \
            _Pragma("unroll") for (int j = 0; j < 4; ++j) { \
                const u32x4 w = xr[64 * j]; const int e4 = 2 * (lane + 64 * j); \
                const f32x4 g0 = gr[e4], g1 = gr[e4 + 1]; \
                __builtin_nontemporal_store((f32x4){bflo(w.x) * rs * g0[0], bfhi(w.x) * rs * g0[1], bflo(w.y) * rs * g0[2], bfhi(w.y) * rs * g0[3]}, orow + e4); \
                __builtin_nontemporal_store((f32x4){bflo(w.z) * rs * g1[0], bfhi(w.z) * rs * g1[1], bflo(w.w) * rs * g1[2], bfhi(w.w) * rs * g1[3]}, orow + e4 + 1); \
            } } } while (0)
__global__ void __launch_bounds__(512, 2) mega_fwd(Params P) {
    extern __shared__ __attribute__((aligned(16))) unsigned char lds_raw[];
    LAS unsigned char* lds = (LAS unsigned char*)lds_raw;
    cg::grid_group grid = cg::this_grid();
    const int G = gridDim.x, bid = blockIdx.x;
    const int NGW = G * 8;
    if (threadIdx.x < 2) ((volatile LAS unsigned*)(lds + MISC_OFF))[threadIdx.x] = 0u;
    { kparams_t KPb = kparams(); if (threadIdx.x == 0) (void)xb_add(&((unsigned*)(KPb->ws + WS_CTL))[XB_XCNT(xb_xcc_id())], 1u); }
    __syncthreads();
    if (PHMASK & (1u << 0)) { PHASE_BEGIN
        LAS float* scr = (LAS float*)(lds + wid * 16640);
        constexpr int I_IN = 32 * 160, I_UP = 32 * 176, I_DN = 88 * 32, I_OUT = 32 * 32, I_A = 16 * 32;
        constexpr int NIT = I_IN + I_UP + I_DN + I_OUT + 2 * I_A;
        REPS(0) for (int it = gw; it < NIT; it += NGW) {
            int r = it;
            if (r < I_IN) { transpose_item(PIN(3), DM, INW, WIN, PIN(2), true, scr, r, lane); continue; } r -= I_IN;
            if (r < I_UP) { transpose_item(PIN(25), DM, UPW, WUP, PIN(24), false, scr, r, lane); continue; } r -= I_UP;
            if (r < I_DN) { transpose_item(PIN(28), DFF, DM, WDN, nullptr, false, scr, r, lane); continue; } r -= I_DN;
            if (r < I_OUT) { transpose_item(PIN(23), DM, DM, WOUT, nullptr, false, scr, r, lane); continue; } r -= I_OUT;
            if (r < I_A) { transpose_item(PIN(21), 1024, DM, WA, nullptr, false, scr, r, lane, 2048, 0); continue; } r -= I_A;
            transpose_item(PIN(22), 1024, DM, WA, nullptr, false, scr, r, lane, 2048, 1024);
        }
        REPS(0) for (int e = bid * 512 + tid; e < 8192 * 32; e += G * 512) {
            const int pos = e >> 5, i = e & 31;
            const float inv = (float)exp2(-(double)(2 * i) / 64.0 * 13.287712379549449);
            const float ang = (float)pos * inv;
            double s, c; sincos_d((double)ang, s, c);
            ROPE[e] = (f32x2){(float)c, (float)s};
        }
        const float* w1 = PIN(12); const float* b1 = PIN(13); const float* w2 = PIN(14); const float* b2 = PIN(15); const float* w3 = PIN(16); const float* b3 = PIN(17); const float* fq_ = PIN(19);
        const float fr = fq_[lane];
        REPS(0) for (int it = gw; it < 4096 + 8192; it += NGW) {
            const int L = it < 4096 ? 4096 : 8192, t = it < 4096 ? it : it - 4096;
            const float tn = (float)t / (float)(L - 1);
            const float w = 6.283185307179586f * (float)t / (float)L;
            float z = 0.f;
            if (lane == 0) z = tn;
            else if (lane <= 32) {
                const int k = (lane - 1) & 15;
                const float f = 1e-4f + (float)k * ((15.0f - 1e-4f) / 15.0f);
                double s, c; sincos_d((double)(f * w), s, c);
                z = (lane <= 16) ? (float)c : (float)(-s);
            }
            float a = b1[lane];
#pragma unroll 11
            for (int e = 0; e < 33; ++e) a += __shfl(z, e) * w1[e * 64 + lane];
            float h = sin_f(fr * a);
            a = b2[lane];
#pragma unroll 16
            for (int e = 0; e < 64; ++e) a += __shfl(h, e) * w2[e * 64 + lane];
            h = sin_f(fr * a);
            a = b3[lane];
#pragma unroll 16
            for (int e = 0; e < 64; ++e) a += __shfl(h, e) * w3[e * 64 + lane];
            h = sin_f(fr * a);
            H3[(size_t)it * 64 + lane] = h;
        }
    }
    grid.sync();
    if (PHMASK & (1u << 1)) { PHASE_BEGIN
        const float* w4 = PIN(18); const float* hb = PIN(20);
        const int NI4 = 64 * 256, NI8 = 128 * 256;
        REPS(1) for (int it = gw; it < NI4 + NI8; it += NGW) {
            const bool is8 = it >= NI4; const int L = is8 ? 8192 : 4096; const int r = is8 ? it - NI4 : it;
            const int tb = r >> 8, cg8 = r & 255; const int t = tb * 64 + lane;
            const float* hrow = H3 + (size_t)((is8 ? 4096 : 0) + t) * 64;
            bf16_t* Fb = is8 ? F8 : F4;
            const float tn = (float)t / (float)(L - 1);
            float acc8[8];
#pragma unroll
            for (int cc = 0; cc < 8; ++cc) acc8[cc] = 0.f;
#pragma unroll 2
            for (int jb = 0; jb < 16; ++jb) {
                const f32x4 h4 = *(const f32x4*)(hrow + 4 * jb);
#pragma unroll
                for (int jj = 0; jj < 4; ++jj) {
                    const f32x4 wa = *(const f32x4*)(w4 + (4 * jb + jj) * 2048 + cg8 * 8), wb = *(const f32x4*)(w4 + (4 * jb + jj) * 2048 + cg8 * 8 + 4);
#pragma unroll
                    for (int e = 0; e < 4; ++e) { acc8[e] += h4[jj] * wa[e]; acc8[4 + e] += h4[jj] * wb[e]; }
                }
            }
#pragma unroll
            for (int cc = 0; cc < 8; ++cc) {
                const int cp = cg8 * 8 + cc;
                const float a = acc8[cc];
                const int c = cp & 1023; const bool bwd = cp >= 1024;
                const float mind = -3.0701134573253946f, maxd = -15.350567286626973f;
                const float delta = fabsf(mind + (float)c * ((maxd - mind) / 1023.0f));
                float val = a * __expf(-tn * delta);
                bf16_t* f0 = Fb + (size_t)c * 4 * L; bf16_t* f1 = f0 + 2 * L;
                if (!bwd) { if (t == 0) val += hb[c]; const int x = L - t; const bf16_t v = (bf16_t)f2bf(val); f0[x] = v; f1[x - 1] = v; }
                else if (t > 0) { const int x = L + t; const bf16_t v = (bf16_t)f2bf(val); f0[x] = v; f1[x - 1] = v; }
                else { f0[0] = 0; f1[2 * L - 1] = 0; }
            }
        }
    }

    if (PHMASK & (1u << 2)) { PHASE_BEGIN BODY_PA(0); }
#pragma unroll 1
    for (int chunk = 0; chunk < NCHUNK; ++chunk) {
        const int L = chunk == 0 ? 4096 : 8192;
#define xin xin_ptr(KP, chunk)
#define outc outc_ptr(KP, chunk)
#define FILT (chunk == 0 ? F4 : F8)
        GSYNC();
        if (PHMASK & (1u << 3)) { PHASE_BEGIN
#pragma unroll 1
            for (int step = 0; step < 2; ++step) {
                if ((step == 0) != ((bid & 1) != 0)) {
                    pg8::Gemm g{XB, WIN, CH, INW, DM}; pg8::StaticOrder S; S.init(CH, INW, G, bid);
                    Epi1 E{QB, KB, VB, HY, GT, XT, RSTD1, PIN(6), ROPE, L};
                    REPS(3) pg8::gemm_phase<Epi1, true>(lds, g, S, E);
                } else if (chunk > 0) { BODY_FINAL(chunk - 1); }
            }
        }
        GSYNC();
        if (PHMASK & (1u << 5)) { PHASE_BEGIN
            const int nqb = L / 256;
            float lam;
            { const float a = wave_sum(PIN(7)[lane] * PIN(8)[lane], lane), b = wave_sum(PIN(9)[lane] * PIN(10)[lane], lane); lam = __expf(a) - __expf(b) + LAMBDA_INIT; }
            const int vb = (G == 256) ? ((bid & 7) * 32 + (bid >> 3)) : bid;
            REPS(5) for (int it0 = vb; it0 < 512; it0 += G) {
                const int it = it0; const int nqsh = (L == 4096) ? 4 : 5; const int qb = it & (nqb - 1), sh = it >> nqsh, h = sh & 7, s = sh >> 3;
                attn_item(lds, QB, KB, VB, AT, s * L, h, qb, L, lam, PIN(11));
            }
            REPS(13) for (int c = bid; c < 1024; c += G) hyena_item(lds, FILT, XT, PIN(4), PIN(5), YT, c, L);
            __syncthreads();
        }
        GSYNC();
        if (PHMASK & (1u << 6)) { PHASE_BEGIN
            const float* cw = PIN(4); const float* cb = PIN(5);
            LAS bf16_t* tl = (LAS bf16_t*)lds;
            for (int tix = bid; tix < 4096; tix += G) {
                const int tb = tix >> 4, cbk = tix & 15;
                { const int ch = tid >> 3, seg = tid & 7; *(LAS u32x4*)(tl + ch * 72 + seg * 8) = *(const u32x4*)(YT + (size_t)(cbk * 64 + ch) * CH + tb * 64 + seg * 8); }
                __syncthreads();
                const int tr = tid >> 3, tc = tid & 7; const int tok = tb * 64 + tr, pos = tok & (L - 1), c0 = cbk * 64 + tc * 8;
                float a[8];
                conv8(HY + (size_t)tok * 3072 + c0, 3072, pos > 0, pos < L - 1, cw + c0, 3072, cb + c0, a);
                u32x4 w;
                w.x = cvt_pk_bf16(a[0] * bf2f(tl[(tc * 8 + 0) * 72 + tr]), a[1] * bf2f(tl[(tc * 8 + 1) * 72 + tr]));
                w.y = cvt_pk_bf16(a[2] * bf2f(tl[(tc * 8 + 2) * 72 + tr]), a[3] * bf2f(tl[(tc * 8 + 3) * 72 + tr]));
                w.z = cvt_pk_bf16(a[4] * bf2f(tl[(tc * 8 + 4) * 72 + tr]), a[5] * bf2f(tl[(tc * 8 + 5) * 72 + tr]));
                w.w = cvt_pk_bf16(a[6] * bf2f(tl[(tc * 8 + 6) * 72 + tr]), a[7] * bf2f(tl[(tc * 8 + 7) * 72 + tr]));
                *(u32x4*)(AT + (size_t)tok * 2048 + 1024 + c0) = w;
                __syncthreads();
            }
        }
        GSYNC();
        if (PHMASK & (1u << 7)) { PHASE_BEGIN
            pg8::Gemm g{AT, WA, CH, DM, DM}; pg8::StaticOrder S; S.init(CH, DM, G, bid);
            Epi2M E{GT, MG};
            pg8::gemm_phase<Epi2M, true>(lds, g, S, E);
        }
        GSYNC();
        if (PHMASK & (1u << 8)) { PHASE_BEGIN
            pg8::Gemm g{MG, WOUT, CH, DM, DM}; pg8::StaticOrder S; S.init(CH, DM, G, bid);
            EpiResB E{XB, X1B, PART1};
            pg8::gemm_phase<EpiResB, true>(lds, g, S, E);
        }
        GSYNC();
        if (PHMASK & (1u << 9)) { PHASE_BEGIN
#pragma unroll 1
            for (int step = 0; step < 2; ++step) {
                if ((step == 0) != ((bid & 1) != 0)) {
                    pg8::Gemm g{X1B, WUP, CH, UPW, DM}; pg8::StaticOrder S; S.init(CH, UPW, G, bid);
                    Epi4 E{UP, PART1};
                    REPS(9) pg8::gemm_phase<Epi4, true>(lds, g, S, E);
                } else if (chunk + 1 < NCHUNK) { BODY_PA(chunk + 1); }
            }
        }
        GSYNC();
        if (PHMASK & (1u << 10)) { PHASE_BEGIN
            const float* cw = PIN(26); const float* cb = PIN(27);
            const int nitems = (CH / 16) * 704;
            REPS(10) for (int it = bid * 512 + tid; it < nitems; it += G * 512) {
                const int cgp = it % 704, rb = it / 704; const int c0 = cgp * 8, r0 = rb * 16; const int pos0 = r0 & (L - 1);
                float wg[3][8], wv[3][8], bg[8], bv[8];
#pragma unroll
                for (int j = 0; j < 3; ++j) {
                    const f32x4 a0 = *(const f32x4*)(cw + j * UPW + c0), a1 = *(const f32x4*)(cw + j * UPW + c0 + 4), b0 = *(const f32x4*)(cw + j * UPW + DFF + c0), b1 = *(const f32x4*)(cw + j * UPW + DFF + c0 + 4);
#pragma unroll
                    for (int e = 0; e < 4; ++e) { wg[j][e] = a0[e]; wg[j][4 + e] = a1[e]; wv[j][e] = b0[e]; wv[j][4 + e] = b1[e]; }
                }
                { const f32x4 a0 = *(const f32x4*)(cb + c0), a1 = *(const f32x4*)(cb + c0 + 4), b0 = *(const f32x4*)(cb + DFF + c0), b1 = *(const f32x4*)(cb + DFF + c0 + 4);
#pragma unroll
                  for (int e = 0; e < 4; ++e) { bg[e] = a0[e]; bg[4 + e] = a1[e]; bv[e] = b0[e]; bv[4 + e] = b1[e]; } }
                const bf16_t* up = UP + (size_t)r0 * UPW + c0;
                const u32x4 z4 = zero4();
                u32x4 pg = (pos0 > 0) ? *(const u32x4*)(up - UPW) : z4, pv = (pos0 > 0) ? *(const u32x4*)(up - UPW + DFF) : z4;
                u32x4 cg_ = *(const u32x4*)up, cv = *(const u32x4*)(up + DFF);
#pragma unroll 4
                for (int rr = 0; rr < 16; ++rr) {
                    const bool hn = (pos0 + rr) < L - 1;
                    const u32x4 ng = hn ? __builtin_nontemporal_load((const u32x4*)(up + (size_t)(rr + 1) * UPW)) : z4, nv = hn ? __builtin_nontemporal_load((const u32x4*)(up + (size_t)(rr + 1) * UPW + DFF)) : z4;
                    float o[8];
#define ACT1(e, PW, CW, NW, PV_, CV_, NV_, SEL) { const float g = wg[0][e] * SEL(PW) + wg[1][e] * SEL(CW) + wg[2][e] * SEL(NW) + bg[e]; const float v = wv[0][e] * SEL(PV_) + wv[1][e] * SEL(CV_) + wv[2][e] * SEL(NV_) + bv[e]; o[e] = g / (1.0f + __expf(-g)) * v; }
                    ACT1(0, pg.x, cg_.x, ng.x, pv.x, cv.x, nv.x, bflo) ACT1(1, pg.x, cg_.x, ng.x, pv.x, cv.x, nv.x, bfhi)
                    ACT1(2, pg.y, cg_.y, ng.y, pv.y, cv.y, nv.y, bflo) ACT1(3, pg.y, cg_.y, ng.y, pv.y, cv.y, nv.y, bfhi)
                    ACT1(4, pg.z, cg_.z, ng.z, pv.z, cv.z, nv.z, bflo) ACT1(5, pg.z, cg_.z, ng.z, pv.z, cv.z, nv.z, bfhi)
                    ACT1(6, pg.w, cg_.w, ng.w, pv.w, cv.w, nv.w, bflo) ACT1(7, pg.w, cg_.w, ng.w, pv.w, cv.w, nv.w, bfhi)
#undef ACT1
                    u32x4 w; w.x = cvt_pk_bf16(o[0], o[1]); w.y = cvt_pk_bf16(o[2], o[3]); w.z = cvt_pk_bf16(o[4], o[5]); w.w = cvt_pk_bf16(o[6], o[7]);
                    *(u32x4*)(ACT + (size_t)(r0 + rr) * DFF + c0) = w;
                    pg = cg_; pv = cv; cg_ = ng; cv = nv;
                }
            }
        }
        GSYNC();
        if (PHMASK & (1u << 11)) { PHASE_BEGIN
            pg8::Gemm g{ACT, WDN, CH, DM, DFF}; pg8::StaticOrder S; S.init(CH, DM, G, bid);
            EpiResB E{X1B, X2B, PART2};
            pg8::gemm_phase<EpiResB, true>(lds, g, S, E);
        }
    }
    GSYNC();
    if (PHMASK & (1u << 12)) { PHASE_BEGIN BODY_FINAL(NCHUNK - 1); }
}

extern "C" void kernel_launch(void* const* d_in, const int* in_sizes, int n_in, void* d_out, int out_size, void* d_ws, size_t ws_size, hipStream_t stream) {
    static int grid = 0;
    if (grid == 0) {
        if (n_in != 30 || ws_size < WS_END) { fprintf(stderr, "kernel_launch: unexpected n_in %d or ws_size %zu\n", n_in, ws_size); grid = -1; return; }
        int dev = 0, cus = 0, per_cu = 0;
        (void)hipGetDevice(&dev);
        (void)hipDeviceGetAttribute(&cus, hipDeviceAttributeMultiprocessorCount, dev);
        (void)hipFuncSetAttribute((const void*)mega_fwd, hipFuncAttributeMaxDynamicSharedMemorySize, LDS_BYTES);
        (void)hipOccupancyMaxActiveBlocksPerMultiprocessor(&per_cu, (const void*)mega_fwd, 512, LDS_BYTES);
        (void)hipGetLastError();
        if (per_cu < 1) per_cu = 1;
        grid = cus;
        fprintf(stderr, "kernel_launch: cus %d per_cu %d grid %d\n", cus, per_cu, grid);
    }
    if (grid < 0) return;
    if (hipMemsetAsync((char*)d_ws + WS_CTL, 0, CTL_BYTES, stream) != hipSuccess) { fprintf(stderr, "kernel_launch: memset failed\n"); return; }
    Params p{};
    for (int i = 0; i < 30; ++i) p.in[i] = (const float*)d_in[i];
    p.out = (float*)d_out; p.ws = (unsigned char*)d_ws;
    void* args[] = {&p};
    hipError_t e = hipLaunchCooperativeKernel((const void*)mega_fwd, dim3(grid), dim3(512), args, LDS_BYTES, stream);
    if (e != hipSuccess) fprintf(stderr, "cooperative launch failed: %s (grid %d)\n", hipGetErrorString(e), grid);
}
```
